# Optimizing an MI355X kernel written in HIP

```python
import math
import jax, jax.numpy as jnp
from jax import lax
import numpy as np


D_MODEL = 1024
BATCH = 4
SEQ = 8192
DEPTH = 1

CHUNK = 64
RWKV_HEADS = 16
RWKV_HEAD_DIM = 64
RWKV_WIDTH = RWKV_HEADS * RWKV_HEAD_DIM
DECAY_LORA = 64
ICLR_LORA = 64
S5_GROUPS = 32
S5_GROUP_DIM = 16
S5_WIDTH = S5_GROUPS * S5_GROUP_DIM
S5_STATE = 64
SHIFT_WIDTH = 3 * RWKV_WIDTH + DECAY_LORA + ICLR_LORA
IN_WIDTH = SHIFT_WIDTH + RWKV_WIDTH + 2 * S5_WIDTH + 2 * D_MODEL
SPLIT_POINTS = (SHIFT_WIDTH,
                SHIFT_WIDTH + RWKV_WIDTH,
                SHIFT_WIDTH + RWKV_WIDTH + S5_WIDTH,
                SHIFT_WIDTH + RWKV_WIDTH + 2 * S5_WIDTH,
                SHIFT_WIDTH + RWKV_WIDTH + 2 * S5_WIDTH + D_MODEL)
RWKV_SPLITS = (RWKV_WIDTH, 2 * RWKV_WIDTH, 3 * RWKV_WIDTH, 3 * RWKV_WIDTH + DECAY_LORA)
RMS_EPS = 1e-6
LNX_EPS = 64e-5
DT_MIN = 1e-3
DT_MAX = 1e-1

kernel_name = 'rwkv7_s5_gated_hybrid_block'


def rms_norm(x, g):
    xf = x.astype(jnp.float32)
    y = xf * lax.rsqrt(jnp.mean(xf * xf, axis=-1, keepdims=True) + RMS_EPS)
    return (y * g.astype(jnp.float32)).astype(x.dtype)


def token_shift(z):
    return jnp.pad(z, ((0, 0), (1, 0), (0, 0)))[:, :-1]


def wkv7(r, w, k, v, a, b):
    bsz, seq, nh, nd = r.shape
    n_chunks = seq // CHUNK

    def to_chunks(t):
        return jnp.moveaxis(t, 1, 0).reshape(n_chunks, CHUNK, bsz, nh, nd)

    def frame_step(S, inp):
        r_t, w_t, k_t, v_t, a_t, b_t = inp
        sa = jnp.einsum('bhij,bhj->bhi', S, a_t)
        S = S * w_t[:, :, None, :] + sa[..., None] * b_t[:, :, None, :] + v_t[..., None] * k_t[:, :, None, :]
        return S, jnp.einsum('bhij,bhj->bhi', S, r_t)

    def chunk_step(S, inp):
        return lax.scan(frame_step, S, inp)

    S0 = jnp.zeros((bsz, nh, nd, nd), jnp.float32)
    _, y = lax.scan(chunk_step, S0, (to_chunks(r), to_chunks(w), to_chunks(k),
                                      to_chunks(v), to_chunks(a), to_chunks(b)))
    return jnp.moveaxis(y.reshape(seq, bsz, nh, nd), 0, 1)


def s5_scan(u, lam_re, lam_im, log_dt, b_re, b_im, c_re, c_im, d_skip):
    f32 = jnp.float32
    lam_re = lam_re.astype(f32)
    lam_im = lam_im.astype(f32)
    dt = jnp.exp(log_dt.astype(f32))[:, None]
    mag = jnp.exp(lam_re * dt)
    ang = lam_im * dt
    ab_re = mag * jnp.cos(ang)
    ab_im = mag * jnp.sin(ang)
    den = lam_re * lam_re + lam_im * lam_im
    nr = ab_re - 1.0
    f_re = (nr * lam_re + ab_im * lam_im) / den
    f_im = (ab_im * lam_re - nr * lam_im) / den
    b_re = b_re.astype(f32)
    b_im = b_im.astype(f32)
    bb_re = f_re[..., None] * b_re - f_im[..., None] * b_im
    bb_im = f_re[..., None] * b_im + f_im[..., None] * b_re
    u_t = jnp.moveaxis(u, 1, 0)
    bu_re = jnp.einsum('lbgh,gph->lbgp', u_t, bb_re)
    bu_im = jnp.einsum('lbgh,gph->lbgp', u_t, bb_im)
    seq = u_t.shape[0]
    a_re = jnp.broadcast_to(ab_re, (seq, 1) + ab_re.shape)
    a_im = jnp.broadcast_to(ab_im, (seq, 1) + ab_im.shape)

    def combine(e1, e2):
        a1r, a1i, b1r, b1i = e1
        a2r, a2i, b2r, b2i = e2
        return (a2r * a1r - a2i * a1i,
                a2r * a1i + a2i * a1r,
                a2r * b1r - a2i * b1i + b2r,
                a2r * b1i + a2i * b1r + b2i)

    _, _, s_re, s_im = lax.associative_scan(combine, (a_re, a_im, bu_re, bu_im), axis=0)
    y = (jnp.einsum('lbgp,ghp->blgh', s_re, c_re.astype(f32))
         - jnp.einsum('lbgp,ghp->blgh', s_im, c_im.astype(f32)))
    return y + d_skip.astype(f32) * u


def setup_inputs(seed: int = 0) -> dict:
    key = jax.random.key(seed)
    ks = jax.random.split(key, 32)
    f32 = jnp.float32
    L = DEPTH

    def nrm(k, shape, scale):
        return scale * jax.random.normal(k, shape, f32)

    x = jax.random.normal(ks[0], (BATCH, SEQ, D_MODEL), f32)
    norm_g = 1.0 + nrm(ks[1], (L, D_MODEL), 0.02)
    w_in = nrm(ks[2], (L, D_MODEL, IN_WIDTH), D_MODEL ** -0.5)
    mu_shift = jax.random.uniform(ks[3], (L, SHIFT_WIDTH), f32, 0.1, 0.9)
    ratio = jnp.arange(RWKV_WIDTH, dtype=f32) / (RWKV_WIDTH - 1)
    w0 = (-7.0 + 5.0 * ratio ** 0.85 + 0.5)[None, :] + nrm(ks[4], (L, RWKV_WIDTH), 0.1)
    w_up = nrm(ks[5], (L, DECAY_LORA, RWKV_WIDTH), 0.5 * DECAY_LORA ** -0.5)
    a0 = nrm(ks[6], (L, RWKV_WIDTH), 0.1)
    a_up = nrm(ks[7], (L, ICLR_LORA, RWKV_WIDTH), 0.5 * ICLR_LORA ** -0.5)
    k_k = 0.85 + nrm(ks[8], (L, RWKV_WIDTH), 0.02)
    k_a = 1.0 + nrm(ks[9], (L, RWKV_WIDTH), 0.02)
    r_k = nrm(ks[10], (L, RWKV_HEADS, RWKV_HEAD_DIM), 0.1)
    lnx_g = 1.0 + nrm(ks[11], (L, RWKV_WIDTH), 0.02)
    lnx_b = nrm(ks[12], (L, RWKV_WIDTH), 0.02)
    n_idx = jnp.arange(S5_STATE, dtype=f32)
    lam_re = -0.5 + nrm(ks[13], (L, S5_GROUPS, S5_STATE), 0.01)
    lam_im = math.pi * n_idx[None, None, :] + nrm(ks[14], (L, S5_GROUPS, S5_STATE), 0.01)
    log_dt = jax.random.uniform(ks[15], (L, S5_GROUPS), f32, math.log(DT_MIN), math.log(DT_MAX))
    b_re = nrm(ks[16], (L, S5_GROUPS, S5_STATE, S5_GROUP_DIM), (2 * S5_GROUP_DIM) ** -0.5)
    b_im = nrm(ks[17], (L, S5_GROUPS, S5_STATE, S5_GROUP_DIM), (2 * S5_GROUP_DIM) ** -0.5)
    c_re = nrm(ks[18], (L, S5_GROUPS, S5_GROUP_DIM, S5_STATE), S5_STATE ** -0.5)
    c_im = nrm(ks[19], (L, S5_GROUPS, S5_GROUP_DIM, S5_STATE), S5_STATE ** -0.5)
    d_skip = nrm(ks[20], (L, S5_GROUPS, S5_GROUP_DIM), 0.5)
    w_glu = nrm(ks[21], (L, S5_WIDTH, 2 * S5_WIDTH), S5_WIDTH ** -0.5)
    b_glu = nrm(ks[22], (L, 2 * S5_WIDTH), 0.02)
    p_a = nrm(ks[23], (L, RWKV_WIDTH, D_MODEL), RWKV_WIDTH ** -0.5)
    p_b = nrm(ks[24], (L, S5_WIDTH, D_MODEL), S5_WIDTH ** -0.5)
    w_out = nrm(ks[25], (L, D_MODEL, D_MODEL), D_MODEL ** -0.5)
    final_g = 1.0 + nrm(ks[26], (D_MODEL,), 0.02)
    return {'x': x, 'norm_g': norm_g, 'w_in': w_in, 'mu_shift': mu_shift, 'w0': w0,
            'w_up': w_up, 'a0': a0, 'a_up': a_up, 'k_k': k_k, 'k_a': k_a, 'r_k': r_k,
            'lnx_g': lnx_g, 'lnx_b': lnx_b, 'lam_re': lam_re, 'lam_im': lam_im,
            'log_dt': log_dt, 'b_re': b_re, 'b_im': b_im, 'c_re': c_re, 'c_im': c_im,
            'd_skip': d_skip, 'w_glu': w_glu, 'b_glu': b_glu, 'p_a': p_a, 'p_b': p_b,
            'w_out': w_out, 'final_g': final_g}


def reference(x, norm_g, w_in, mu_shift, w0, w_up, a0, a_up, k_k, k_a, r_k, lnx_g, lnx_b,
              lam_re, lam_im, log_dt, b_re, b_im, c_re, c_im, d_skip, w_glu, b_glu,
              p_a, p_b, w_out, final_g):
    f32 = jnp.float32
    bsz, seq, _ = x.shape
    H, N = RWKV_HEADS, RWKV_HEAD_DIM

    def heads(t):
        return t.reshape(bsz, seq, H, N).astype(f32)

    for l in range(DEPTH):
        h = rms_norm(x, norm_g[l])
        z = h @ w_in[l]
        zs, gate_a, u, gate_b, m_a, m_b = jnp.split(z, SPLIT_POINTS, axis=-1)

        zs = zs + mu_shift[l] * (token_shift(zs) - zs)
        r, k, v, xw, xa = jnp.split(zs, RWKV_SPLITS, axis=-1)
        w_log = -jax.nn.softplus(-(w0[l] + jnp.tanh(xw) @ w_up[l]).astype(f32)) - 0.5
        decay = jnp.exp(-jnp.exp(w_log))
        iclr = jax.nn.sigmoid((a0[l] + xa @ a_up[l]).astype(f32))
        iclr_h = iclr.reshape(bsz, seq, H, N)
        kk = heads(k * k_k[l])
        kk = kk / jnp.maximum(jnp.sqrt(jnp.sum(kk * kk, axis=-1, keepdims=True)), 1e-12)
        ka = k_a[l].reshape(H, N).astype(f32)
        k_h = heads(k) * (1.0 + (iclr_h - 1.0) * ka)
        r_h = heads(r)
        v_h = heads(v)
        y = wkv7(r_h, decay.reshape(bsz, seq, H, N), k_h, v_h, -kk, kk * iclr_h)
        mu = jnp.mean(y, axis=-1, keepdims=True)
        var = jnp.mean(jnp.square(y - mu), axis=-1, keepdims=True)
        y = (y - mu) * lax.rsqrt(var + LNX_EPS)
        y = y * lnx_g[l].reshape(H, N).astype(f32) + lnx_b[l].reshape(H, N).astype(f32)
        y = y + jnp.sum(r_h * k_h * r_k[l].astype(f32), axis=-1, keepdims=True) * v_h
        y_a = y.reshape(bsz, seq, RWKV_WIDTH).astype(x.dtype) * jax.nn.silu(gate_a)

        ys = s5_scan(u.reshape(bsz, seq, S5_GROUPS, S5_GROUP_DIM).astype(f32),
                     lam_re[l], lam_im[l], log_dt[l], b_re[l], b_im[l], c_re[l], c_im[l], d_skip[l])
        ys = jax.nn.gelu(ys.reshape(bsz, seq, S5_WIDTH).astype(x.dtype))
        g1, g2 = jnp.split(ys @ w_glu[l] + b_glu[l], 2, axis=-1)
        y_b = g1 * jax.nn.sigmoid(g2) * jax.nn.silu(gate_b)

        merged = jax.nn.sigmoid(m_a) * (y_a @ p_a[l]) + jax.nn.sigmoid(m_b) * (y_b @ p_b[l])
        x = x + merged @ w_out[l]
    return rms_norm(x, final_g)
```

```cpp
#include <hip/hip_runtime.h>
#include <hip/hip_cooperative_groups.h>
#include <cstdio>
#include <cstdint>
namespace cg = cooperative_groups;

#ifndef MK_MULTI
#define MK_MULTI 0
#endif

#define LAS __attribute__((address_space(3)))
typedef unsigned short bf16_t;
typedef short bf16x8 __attribute__((ext_vector_type(8)));
typedef float f32x4 __attribute__((ext_vector_type(4)));
typedef float f32x2 __attribute__((ext_vector_type(2)));
typedef unsigned u32x4 __attribute__((ext_vector_type(4)));
typedef unsigned u32x2 __attribute__((ext_vector_type(2)));

constexpr int DM = 1024, NBATCH = 4, SEQ = 8192, NTOK = NBATCH * SEQ;
constexpr int INW = 7296, INWP = 7424;
constexpr size_t MiB = (size_t)1 << 20;
constexpr size_t WS_ZR = 1 * MiB, WS_ZK = 65 * MiB, WS_ZV = 129 * MiB, WS_ZGA = 193 * MiB, WS_ZU = 257 * MiB, WS_ZGB = 289 * MiB,
                 WS_ZMA = 321 * MiB, WS_ZMB = 385 * MiB, WS_ZX = 449 * MiB;
constexpr size_t WS_WIN = 465 * MiB, WS_WGLU = 480 * MiB, WS_WPA = 481 * MiB, WS_WPB = 483 * MiB, WS_WOUT = 484 * MiB, WS_WUP = 486 * MiB,
                 WS_AUP = 486 * MiB + 256 * 1024, WS_RK = 487 * MiB, WS_SLOC = 489 * MiB, WS_SSTART = 491 * MiB, WS_S5C = 493 * MiB, WS_END = 494 * MiB;
constexpr size_t S5_AB = 0, S5_APOW = 16384, S5_BBRE = 32768, S5_BBIM = 32768 + 131072, S5_CMT = 32768 + 262144  ;
constexpr size_t WS_IC = WS_ZU;
constexpr size_t WS_EE = WS_ZMB;
constexpr size_t WS_INVN = WS_SLOC;
constexpr size_t WS_YA = WS_ZR;
constexpr size_t WS_OB = WS_ZV;
constexpr size_t WS_MERGED = WS_ZK;
constexpr size_t OUT_YSG = 0, OUT_YB = 32 * MiB, OUT_MB = 64 * MiB;
constexpr int LDS_BYTES = 131072 + 32;
constexpr int NPHASE = 12;

struct Params { const float* in[27]; float* out; unsigned char* ws; int ph_lo, ph_hi; };

__device__ __forceinline__ unsigned pk2bf(float lo, float hi) { unsigned r; asm volatile("v_cvt_pk_bf16_f32 %0, %1, %2" : "=v"(r) : "v"(lo), "v"(hi)); return r; }
__device__ __forceinline__ bf16_t f2bf(float f) { return (bf16_t)(pk2bf(f, 0.f) & 0xffffu); }
__device__ __forceinline__ float bf2f(bf16_t v) { return __uint_as_float(((unsigned)v) << 16); }
__device__ __forceinline__ float bflo(unsigned w) { return __uint_as_float(w << 16); }
__device__ __forceinline__ float bfhi(unsigned w) { return __uint_as_float(w & 0xffff0000u); }
#define UNPACK8(v, f) do { (f)[0] = bflo((v).x); (f)[1] = bfhi((v).x); (f)[2] = bflo((v).y); (f)[3] = bfhi((v).y); (f)[4] = bflo((v).z); (f)[5] = bfhi((v).z); (f)[6] = bflo((v).w); (f)[7] = bfhi((v).w); } while (0)
__device__ __forceinline__ float fsigmoid(float x) { return __builtin_amdgcn_rcpf(1.0f + __expf(-x)); }
__device__ __forceinline__ float ftanh(float x) { const float t = __expf(2.0f * x); return 1.0f - 2.0f * __builtin_amdgcn_rcpf(t + 1.0f); }
__device__ __forceinline__ float fgelu_tanh(float x) { return 0.5f * x * (1.0f + ftanh(0.7978845608028654f * (x + 0.044715f * x * x * x))); }
template <int CTRL> __device__ __forceinline__ float dppf(float v) { return __int_as_float(__builtin_amdgcn_update_dpp(0, __float_as_int(v), CTRL, 0xf, 0xf, true)); }
__device__ __forceinline__ float allred16(float p) { p += dppf<0xB1>(p); p += dppf<0x4E>(p); p += dppf<0x124>(p); p += dppf<0x128>(p); return p; }
__device__ __forceinline__ float allred4(float p) { p += dppf<0xB1>(p); p += dppf<0x4E>(p); return p; }
__device__ __forceinline__ float allred64(float p) { p = allred16(p); p += __shfl_xor(p, 16); p += __shfl_xor(p, 32); return p; }
__device__ __forceinline__ void wave_lds_sync() { asm volatile("s_waitcnt lgkmcnt(0)" ::: "memory"); __builtin_amdgcn_wave_barrier(); asm volatile("" ::: "memory"); }

namespace pg8 {
constexpr int BM = 256, BK = 64, HALF = 128, HTB = HALF * BK * 2, STAGE_BYTES = 8 * HTB, NXCD = 8, WGM = 8;
__host__ __device__ __forceinline__ int lds_byte(int r, int c) { const int st = (r >> 4) * 2 + (c >> 5), rr = r & 15, cc = c & 31, ob = rr * 64 + cc * 2; return st * 1024 + (ob ^ (((ob >> 9) & 1) << 5)); }
__host__ __device__ __forceinline__ void stage_rc(int b, int& R, int& C) { const int st = b / 1024, sb = b % 1024, swz = sb ^ (((sb >> 9) & 1) << 5); R = (st >> 1) * 16 + swz / 64; C = (st & 1) * 32 + (swz % 64) / 2; }
__host__ __device__ __forceinline__ int perm32(int rho) { const int n = rho >> 4, i = rho & 15; return 8 * (i >> 2) + 4 * n + (i & 3); }
struct Unit { int pm, pn; };
struct Gemm { const bf16_t* A; const bf16_t* Bt; int M, N, K; };
struct StaticOrder {
    int nM, nN, nwg, G, c;
    __host__ __device__ void init(int M, int N, int G_, int c_) { nM = M / BM; nN = N / BM; nwg = nM * nN; G = G_; c = c_; }
    __host__ __device__ bool next(int i, Unit& u) const {
        const long L = (long)i * G + c; if (L >= nwg) return false;
        int wgid = (int)L; { const int q = nwg / NXCD, r = nwg % NXCD, xcd = wgid % NXCD, off = wgid / NXCD; wgid = (xcd < r ? xcd * (q + 1) : r * (q + 1) + (xcd - r) * q) + off; }
        const int nig = WGM * nN, gid = wgid / nig, fm = gid * WGM, gsz = (nM - fm) < WGM ? (nM - fm) : WGM;
        u.pm = fm + ((wgid % nig) % gsz); u.pn = (wgid % nig) / gsz; return true;
    }
};

template <class Epi>
__device__ __forceinline__ void gemm_phase(LAS unsigned char* lds, const Gemm g, const StaticOrder& S, const Epi& E) {
    const int tid = threadIdx.x, wid = __builtin_amdgcn_readfirstlane(tid >> 6), lane = tid & 63, wr = wid >> 2, wc = wid & 3, fr = lane & 15, fq = lane >> 4;
    const int K = g.K, nt = K / BK;
    unsigned voffA[2], voffB[2];
#pragma unroll
    for (int i = 0; i < 2; ++i) { int R, C; stage_rc(tid * 16 + i * 8192, R, C); const int Rb = Epi::PERM ? ((R & ~31) + perm32(R & 31)) : R;
        voffA[i] = (unsigned)(R * K + C) * 2u; voffB[i] = (unsigned)(Rb * K + C) * 2u; }
    const size_t kstep = (size_t)(BK * 2);
    const size_t hstep = (size_t)HALF * K * 2;
    const size_t tstep = 2 * hstep;
    const unsigned ldsw = (unsigned)wid * 1024u;
    const int aoff = lds_byte(wr * 64 + fr, fq * 8), boff = lds_byte(wc * 32 + fr, fq * 8);
#define PG8_SA(b, h) (((b) * 2 + (h)) * HTB)
#define PG8_SB(b, h) ((4 + (b) * 2 + (h)) * HTB)
#define PG8_STAGE(bufoff, gbase, voff) do { _Pragma("unroll") for (int _i = 0; _i < 2; ++_i) \
        __builtin_amdgcn_global_load_lds((const unsigned*)((const char*)(gbase) + (voff)[_i]), (LAS unsigned*)(lds + (bufoff) + ldsw + _i * 8192), 16, 0, 0); } while (0)
#define PG8_LDA(dst, b, h) do { _Pragma("unroll") for (int m = 0; m < 4; ++m) _Pragma("unroll") for (int k = 0; k < 2; ++k) dst[m][k] = *(const LAS bf16x8*)(lds + PG8_SA(b, h) + aoff + m * 2048 + k * 1024); } while (0)
#define PG8_LDB(dst, b, h) do { _Pragma("unroll") for (int n = 0; n < 2; ++n) _Pragma("unroll") for (int k = 0; k < 2; ++k) dst[n][k] = *(const LAS bf16x8*)(lds + PG8_SB(b, h) + boff + n * 2048 + k * 1024); } while (0)
#define PG8_MMA(ai, bj, At, Bt) do { __builtin_amdgcn_s_setprio(1); _Pragma("unroll") for (int m = 0; m < 4; ++m) _Pragma("unroll") for (int n = 0; n < 2; ++n) _Pragma("unroll") for (int k = 0; k < 2; ++k) \
        acc[ai][bj][m][n] = __builtin_amdgcn_mfma_f32_16x16x32_bf16(Bt[n][k], At[m][k], acc[ai][bj][m][n], 0, 0, 0); __builtin_amdgcn_s_setprio(0); } while (0)
#define PG8_WAIT_V(n) asm volatile("s_waitcnt vmcnt(" #n ")" ::: "memory")
#define PG8_WAIT_L(n) asm volatile("s_waitcnt lgkmcnt(" #n ")" ::: "memory")
#define PG8_BAR __builtin_amdgcn_s_barrier()
#define PG8_SCHED __builtin_amdgcn_sched_barrier(0)
    Unit cur, nxt; int ui = 0;
    if (!S.next(0, cur)) return;
    f32x4 acc[2][2][4][2];
#pragma unroll
    for (int a = 0; a < 2; ++a)
#pragma unroll
        for (int b = 0; b < 2; ++b)
#pragma unroll
            for (int m = 0; m < 4; ++m)
#pragma unroll
                for (int n = 0; n < 2; ++n) acc[a][b][m][n] = (f32x4){0.f, 0.f, 0.f, 0.f};
    bf16x8 At[4][2], B0[2][2], B1[2][2];
    const char* cA = (const char*)g.A + (size_t)cur.pm * tstep; const char* cB = (const char*)g.Bt + (size_t)cur.pn * tstep;
    PG8_STAGE(PG8_SB(0, 0), cB, voffB); PG8_STAGE(PG8_SA(0, 0), cA, voffA); PG8_STAGE(PG8_SB(0, 1), cB + hstep, voffB); PG8_STAGE(PG8_SA(0, 1), cA + hstep, voffA);
    if (wr == 1) PG8_BAR;
    PG8_WAIT_V(4); PG8_BAR;
    PG8_STAGE(PG8_SB(1, 0), cB + kstep, voffB); PG8_STAGE(PG8_SA(1, 0), cA + kstep, voffA); PG8_STAGE(PG8_SB(1, 1), cB + hstep + kstep, voffB);
    PG8_WAIT_V(6); PG8_BAR;
    for (;;) {
        const bool has_next = S.next(ui + 1, nxt);
        const char* nA = has_next ? (const char*)g.A + (size_t)nxt.pm * tstep : cA; const char* nB = has_next ? (const char*)g.Bt + (size_t)nxt.pn * tstep : cB;
        for (int t = 0; t < nt; t += 2) {
            const bool last = (t == nt - 2);
            const char* a1 = cA + (size_t)(t + 1) * kstep;
            const char* a2 = last ? nA : cA + (size_t)(t + 2) * kstep; const char* b2 = last ? nB : cB + (size_t)(t + 2) * kstep;
            const char* a3 = a2 + kstep; const char* b3 = b2 + kstep;
            PG8_LDB(B0, 0, 0); PG8_SCHED; PG8_LDA(At, 0, 0); PG8_STAGE(PG8_SA(1, 1), a1 + hstep, voffA);
            PG8_WAIT_L(8); PG8_BAR; PG8_WAIT_L(0); PG8_MMA(0, 0, At, B0); PG8_BAR; PG8_SCHED;
            PG8_LDB(B1, 0, 1); PG8_STAGE(PG8_SB(0, 0), b2, voffB);
            PG8_BAR; PG8_WAIT_L(0); PG8_MMA(0, 1, At, B1); PG8_BAR;
            PG8_LDA(At, 0, 1); PG8_STAGE(PG8_SA(0, 0), a2, voffA);
            PG8_BAR; PG8_WAIT_L(0); PG8_MMA(1, 0, At, B0); PG8_BAR; PG8_SCHED;
            PG8_STAGE(PG8_SB(0, 1), b2 + hstep, voffB);
            PG8_WAIT_V(6); PG8_BAR; PG8_MMA(1, 1, At, B1); PG8_BAR;
            PG8_LDB(B0, 1, 0); PG8_SCHED; PG8_LDA(At, 1, 0); PG8_STAGE(PG8_SA(0, 1), a2 + hstep, voffA);
            PG8_WAIT_L(8); PG8_BAR; PG8_WAIT_L(0); PG8_MMA(0, 0, At, B0); PG8_BAR; PG8_SCHED;
            PG8_LDB(B1, 1, 1); PG8_STAGE(PG8_SB(1, 0), b3, voffB);
            PG8_BAR; PG8_WAIT_L(0); PG8_MMA(0, 1, At, B1); PG8_BAR;
            PG8_LDA(At, 1, 1); PG8_STAGE(PG8_SA(1, 0), a3, voffA);
            PG8_BAR; PG8_WAIT_L(0); PG8_MMA(1, 0, At, B0); PG8_BAR; PG8_SCHED;
            PG8_STAGE(PG8_SB(1, 1), b3 + hstep, voffB);
            PG8_WAIT_V(6); PG8_BAR; PG8_MMA(1, 1, At, B1); PG8_BAR;
        }
        E(acc, cur, wr, wc, fr, fq);
        if (!has_next) break;
#pragma unroll
        for (int a = 0; a < 2; ++a)
#pragma unroll
            for (int b = 0; b < 2; ++b)
#pragma unroll
                for (int m = 0; m < 4; ++m)
#pragma unroll
                    for (int n = 0; n < 2; ++n) acc[a][b][m][n] = (f32x4){0.f, 0.f, 0.f, 0.f};
        cur = nxt; cA = nA; cB = nB; ++ui;
    }
    PG8_WAIT_V(0);
    if (wr == 0) PG8_BAR;
    PG8_BAR;
#undef PG8_SA
#undef PG8_SB
#undef PG8_STAGE
#undef PG8_LDA
#undef PG8_LDB
#undef PG8_MMA
#undef PG8_WAIT_V
#undef PG8_WAIT_L
#undef PG8_BAR
#undef PG8_SCHED
}
}

typedef f32x4 AccT[2][2][4][2];
struct EpiZ {
    static constexpr bool PERM = true;
    unsigned char* ws;
    __device__ __forceinline__ void operator()(const AccT& acc, const pg8::Unit& u, int wr, int wc, int fr, int fq) const {
        const int pn = u.pn; size_t base; int ld, c0;
        if (pn < 16) { base = WS_ZR + (size_t)(pn >> 2) * (64 * MiB); ld = 1024; c0 = (pn & 3) * 256; }
        else if (pn < 18) { base = WS_ZU; ld = 512; c0 = (pn - 16) * 256; }
        else if (pn < 20) { base = WS_ZGB; ld = 512; c0 = (pn - 18) * 256; }
        else if (pn < 24) { base = WS_ZMA; ld = 1024; c0 = (pn - 20) * 256; }
        else if (pn < 28) { base = WS_ZMB; ld = 1024; c0 = (pn - 24) * 256; }
        else { base = WS_ZX; ld = 256; c0 = 0; }
        bf16_t* O = (bf16_t*)(ws + base);
        const int row0 = u.pm * 256 + wr * 64 + fr, col0 = c0 + wc * 32 + 8 * fq;
#pragma unroll
        for (int ai = 0; ai < 2; ++ai)
#pragma unroll
            for (int m = 0; m < 4; ++m) { bf16_t* rowp = O + (size_t)(row0 + ai * 128 + m * 16) * ld + col0;
#pragma unroll
                for (int bj = 0; bj < 2; ++bj) { const f32x4 v0 = acc[ai][bj][m][0], v1 = acc[ai][bj][m][1];
                    u32x4 w; w.x = pk2bf(v0[0], v0[1]); w.y = pk2bf(v0[2], v0[3]); w.z = pk2bf(v1[0], v1[1]); w.w = pk2bf(v1[2], v1[3]);
                    *(u32x4*)(rowp + bj * 128) = w; } }
    }
};
struct EpiGlu {
    static constexpr bool PERM = true;
    unsigned char* ws; const float* bglu; bf16_t* yb;
    __device__ __forceinline__ void operator()(const AccT& acc, const pg8::Unit& u, int wr, int wc, int fr, int fq) const {
        const int j0 = u.pn * 128 + wc * 32 + 8 * fq; const int row0 = u.pm * 256 + wr * 64 + fr;
        const bf16_t* zgb = (const bf16_t*)(ws + WS_ZGB);
        u32x4 gvv[2][4];
#pragma unroll
        for (int ai = 0; ai < 2; ++ai)
#pragma unroll
            for (int m = 0; m < 4; ++m) gvv[ai][m] = *(const u32x4*)(zgb + (size_t)(row0 + ai * 128 + m * 16) * 512 + j0);
        const f32x4 b1a = *(const f32x4*)(bglu + j0), b1b = *(const f32x4*)(bglu + j0 + 4), b2a = *(const f32x4*)(bglu + 512 + j0), b2b = *(const f32x4*)(bglu + 512 + j0 + 4);
#pragma unroll
        for (int ai = 0; ai < 2; ++ai)
#pragma unroll
            for (int m = 0; m < 4; ++m) { const size_t row = (size_t)(row0 + ai * 128 + m * 16);
                float gt[8]; UNPACK8(gvv[ai][m], gt);
                float o[8];
#pragma unroll
                for (int e = 0; e < 8; ++e) { const float g1 = acc[ai][0][m][e >> 2][e & 3] + ((e < 4) ? b1a[e & 3] : b1b[e & 3]);
                    const float g2 = acc[ai][1][m][e >> 2][e & 3] + ((e < 4) ? b2a[e & 3] : b2b[e & 3]);
                    o[e] = g1 * fsigmoid(g2) * gt[e] * fsigmoid(gt[e]); }
                u32x4 w; w.x = pk2bf(o[0], o[1]); w.y = pk2bf(o[2], o[3]); w.z = pk2bf(o[4], o[5]); w.w = pk2bf(o[6], o[7]);
                *(u32x4*)(yb + row * 512 + j0) = w; }
    }
};
template <int MODE> struct EpiGate {
    static constexpr bool PERM = true;
    const bf16_t* gate; const bf16_t* addend; bf16_t* O;
    __device__ __forceinline__ void operator()(const AccT& acc, const pg8::Unit& u, int wr, int wc, int fr, int fq) const {
        const int row0 = u.pm * 256 + wr * 64 + fr, col0 = u.pn * 256 + wc * 32 + 8 * fq;
#pragma unroll
        for (int ai = 0; ai < 2; ++ai) {
            u32x4 gvv[4][2], avv[4][2];
#pragma unroll
            for (int m = 0; m < 4; ++m)
#pragma unroll
                for (int bj = 0; bj < 2; ++bj) { const size_t ro = (size_t)(row0 + ai * 128 + m * 16) * 1024 + col0 + bj * 128;
                    gvv[m][bj] = *(const u32x4*)(gate + ro); if (MODE == 1) avv[m][bj] = *(const u32x4*)(addend + ro); }
#pragma unroll
            for (int m = 0; m < 4; ++m)
#pragma unroll
                for (int bj = 0; bj < 2; ++bj) { const size_t ro = (size_t)(row0 + ai * 128 + m * 16) * 1024 + col0 + bj * 128;
                    float gt[8], ad[8]; UNPACK8(gvv[m][bj], gt);
                    if (MODE == 1) UNPACK8(avv[m][bj], ad);
                    float o[8];
#pragma unroll
                    for (int e = 0; e < 8; ++e) { o[e] = acc[ai][bj][m][e >> 2][e & 3] * fsigmoid(gt[e]); if (MODE == 1) o[e] += ad[e]; }
                    u32x4 w; w.x = pk2bf(o[0], o[1]); w.y = pk2bf(o[2], o[3]); w.z = pk2bf(o[4], o[5]); w.w = pk2bf(o[6], o[7]);
                    *(u32x4*)(O + ro) = w; }
        }
    }
};
struct EpiOut {
    static constexpr bool PERM = true;
    bf16_t* O;
    __device__ __forceinline__ void operator()(const AccT& acc, const pg8::Unit& u, int wr, int wc, int fr, int fq) const {
        const int row0 = u.pm * 256 + wr * 64 + fr, col0 = u.pn * 256 + wc * 32 + 8 * fq;
#pragma unroll
        for (int ai = 0; ai < 2; ++ai)
#pragma unroll
            for (int m = 0; m < 4; ++m) { bf16_t* rowp = O + (size_t)(row0 + ai * 128 + m * 16) * 1024 + col0;
#pragma unroll
                for (int bj = 0; bj < 2; ++bj) { const f32x4 v0 = acc[ai][bj][m][0], v1 = acc[ai][bj][m][1];
                    u32x4 w; w.x = pk2bf(v0[0], v0[1]); w.y = pk2bf(v0[2], v0[3]); w.z = pk2bf(v1[0], v1[1]); w.w = pk2bf(v1[2], v1[3]);
                    *(u32x4*)(rowp + bj * 128) = w; } }
    }
};

__device__ __forceinline__ void sincos_d(double x, double& s, double& c) {
    const double n = rint(x * 0.15915494309189533577);
    double r = fma(-n, 6.283185307179586476925, x); r = fma(-n, 2.4492935982947064e-16, r);
    const double r2 = r * r;
    double t = -1.0 / 1.0888869450418352e28;
    t = fma(t, r2, 1.0 / 1.5511210043330986e25);
    t = fma(t, r2, -1.0 / 2.5852016738884978e22);
    t = fma(t, r2, 1.0 / 5.109094217170944e19);
    t = fma(t, r2, -1.0 / 1.21645100408832e17);
    t = fma(t, r2, 1.0 / 355687428096000.0);
    t = fma(t, r2, -1.0 / 1307674368000.0);
    t = fma(t, r2, 1.0 / 6227020800.0);
    t = fma(t, r2, -1.0 / 39916800.0);
    t = fma(t, r2, 1.0 / 362880.0);
    t = fma(t, r2, -1.0 / 5040.0);
    t = fma(t, r2, 1.0 / 120.0);
    t = fma(t, r2, -1.0 / 6.0);
    t = fma(t, r2, 1.0);
    s = r * t;
    double q = 1.0 / 3.0488834461171384e29;
    q = fma(q, r2, -1.0 / 4.0329146112660565e26);
    q = fma(q, r2, 1.0 / 6.204484017332394e23);
    q = fma(q, r2, -1.0 / 1.1240007277776077e21);
    q = fma(q, r2, 1.0 / 2.43290200817664e18);
    q = fma(q, r2, -1.0 / 6402373705728000.0);
    q = fma(q, r2, 1.0 / 20922789888000.0);
    q = fma(q, r2, -1.0 / 87178291200.0);
    q = fma(q, r2, 1.0 / 479001600.0);
    q = fma(q, r2, -1.0 / 3628800.0);
    q = fma(q, r2, 1.0 / 40320.0);
    q = fma(q, r2, -1.0 / 720.0);
    q = fma(q, r2, 1.0 / 24.0);
    q = fma(q, r2, -0.5);
    q = fma(q, r2, 1.0);
    c = q;
}

__device__ __forceinline__ void transpose_tile(const float* W, int ldw, int scol0, int k0, bf16_t* Wt, int ldt, int drow0, bool zero, float* tile, int tid) {
#pragma unroll
    for (int i = 0; i < 2; ++i) { const int kk = (tid >> 4) + i * 32, nn = (tid & 15) * 4;
        f32x4 v = (f32x4){0.f, 0.f, 0.f, 0.f};
        if (!zero) v = *(const f32x4*)(W + (size_t)(k0 + kk) * ldw + scol0 + nn);
        tile[kk * 65 + nn + 0] = v[0]; tile[kk * 65 + nn + 1] = v[1]; tile[kk * 65 + nn + 2] = v[2]; tile[kk * 65 + nn + 3] = v[3]; }
    __syncthreads();
    { const int n = tid >> 3, kq = (tid & 7) * 8;
      u32x4 o; o.x = pk2bf(tile[(kq + 0) * 65 + n], tile[(kq + 1) * 65 + n]); o.y = pk2bf(tile[(kq + 2) * 65 + n], tile[(kq + 3) * 65 + n]);
      o.z = pk2bf(tile[(kq + 4) * 65 + n], tile[(kq + 5) * 65 + n]); o.w = pk2bf(tile[(kq + 6) * 65 + n], tile[(kq + 7) * 65 + n]);
      *(u32x4*)(Wt + (size_t)(drow0 + n) * ldt + k0 + kq) = o; }
    __syncthreads();
}

__device__ void phase_prologue(const Params& p, unsigned char* ldsg) {
    float* tile = (float*)ldsg;
    const int tid = threadIdx.x, bid = blockIdx.x, G = gridDim.x, lane = tid & 63, wave = tid >> 6;
    unsigned char* ws = p.ws;
    for (int job = bid; job < 2656; job += G) {
        const float* W; int ldw, scol0, k0, ldt, drow0; bf16_t* Wt; bool zero = false; int j = job;
        if (j < 1856) { const int nt = j >> 4, kt = j & 15, n = nt * 64; W = p.in[2]; ldw = INW; k0 = kt * 64; Wt = (bf16_t*)(ws + WS_WIN); ldt = 1024; drow0 = n;
            if (n < 3072) scol0 = n; else if (n < 7168) scol0 = n + 128; else if (n < 7296) scol0 = n - 4096; else { scol0 = 0; zero = true; } }
        else if ((j -= 1856) < 128) { const int nt = j >> 3, kt = j & 7; W = p.in[21]; ldw = 1024; k0 = kt * 64; Wt = (bf16_t*)(ws + WS_WGLU); ldt = 512; drow0 = nt * 64;
            scol0 = ((nt & 3) >> 1) * 512 + (nt >> 2) * 128 + (nt & 1) * 64; }
        else if ((j -= 128) < 256) { const int nt = j >> 4, kt = j & 15; W = p.in[23]; ldw = 1024; k0 = kt * 64; Wt = (bf16_t*)(ws + WS_WPA); ldt = 1024; drow0 = nt * 64; scol0 = nt * 64; }
        else if ((j -= 256) < 128) { const int nt = j >> 3, kt = j & 7; W = p.in[24]; ldw = 1024; k0 = kt * 64; Wt = (bf16_t*)(ws + WS_WPB); ldt = 512; drow0 = nt * 64; scol0 = nt * 64; }
        else if ((j -= 128) < 256) { const int nt = j >> 4, kt = j & 15; W = p.in[25]; ldw = 1024; k0 = kt * 64; Wt = (bf16_t*)(ws + WS_WOUT); ldt = 1024; drow0 = nt * 64; scol0 = nt * 64; }
        else { j -= 256; const int nt = j & 15; W = (j < 16) ? p.in[5] : p.in[7]; ldw = 1024; k0 = 0; Wt = (bf16_t*)(ws + ((j < 16) ? WS_WUP : WS_AUP)); ldt = 64; drow0 = nt * 64; scol0 = nt * 64; }
        transpose_tile(W, ldw, scol0, k0, Wt, ldt, drow0, zero, tile, tid);
    }
    {
        const float* x = p.in[0]; const float* gn = p.in[1]; bf16_t* hb = (bf16_t*)p.out;
        f32x4 gv[4];
#pragma unroll
        for (int i = 0; i < 4; ++i) gv[i] = *(const f32x4*)(gn + i * 256 + lane * 4);
        for (int row = bid * 8 + wave; row < NTOK; row += G * 8) {
            f32x4 v[4]; float ss = 0.f;
#pragma unroll
            for (int i = 0; i < 4; ++i) { v[i] = *(const f32x4*)(x + (size_t)row * 1024 + i * 256 + lane * 4); ss += v[i][0] * v[i][0] + v[i][1] * v[i][1] + v[i][2] * v[i][2] + v[i][3] * v[i][3]; }
            ss = allred64(ss);
            const float rs = rsqrtf(ss * (1.0f / 1024.0f) + 1e-6f);
#pragma unroll
            for (int i = 0; i < 4; ++i) { u32x2 o; o.x = pk2bf(v[i][0] * rs * gv[i][0], v[i][1] * rs * gv[i][1]); o.y = pk2bf(v[i][2] * rs * gv[i][2], v[i][3] * rs * gv[i][3]);
                *(u32x2*)(hb + (size_t)row * 1024 + i * 256 + lane * 4) = o; }
        }
    }
    {
        const int idx = bid * 512 + tid;
        if (idx < 2048) {
            const int g = idx >> 6, pp = idx & 63;
            const double dt = exp((double)p.in[15][g]); const double lr = (double)p.in[13][idx], li = (double)p.in[14][idx];
            const double mag = exp(lr * dt); double sn, cs; sincos_d(li * dt, sn, cs);
            const double abr = mag * cs, abi = mag * sn;
            const double den = lr * lr + li * li, nr = abr - 1.0;
            const double fre = (nr * lr + abi * li) / den, fim = (abi * lr - nr * li) / den;
            ((f32x2*)(ws + WS_S5C + S5_AB))[idx] = (f32x2){(float)abr, (float)abi};
            const double mag2 = exp(lr * dt * 256.0); double sn2, cs2; sincos_d(li * dt * 256.0, sn2, cs2);
            ((f32x2*)(ws + WS_S5C + S5_APOW))[idx] = (f32x2){(float)(mag2 * cs2), (float)(mag2 * sn2)};
            bf16_t* bbt = (bf16_t*)(ws + WS_S5C + S5_BBRE);
            for (int h = 0; h < 16; ++h) { const double br = (double)p.in[16][idx * 16 + h], bi = (double)p.in[17][idx * 16 + h];
                bbt[(size_t)(g * 128 + pp) * 16 + h] = f2bf((float)(fre * br - fim * bi)); bbt[(size_t)(g * 128 + 64 + pp) * 16 + h] = f2bf((float)(fre * bi + fim * br)); }
            bf16_t* cmt = (bf16_t*)(ws + WS_S5C + S5_CMT);
            for (int h = 0; h < 16; ++h) { cmt[(g * 16 + h) * 128 + 2 * pp] = f2bf(p.in[18][(g * 16 + h) * 64 + pp]); cmt[(g * 16 + h) * 128 + 2 * pp + 1] = f2bf(-p.in[19][(g * 16 + h) * 64 + pp]); }
        }
    }
}

__device__ __forceinline__ void shift8(const u32x4& cv, const u32x4& pv, const f32x4& m0, const f32x4& m1, bool first, float* o) {
    float c[8], pr[8]; UNPACK8(cv, c); UNPACK8(pv, pr);
#pragma unroll
    for (int e = 0; e < 8; ++e) { const float pe = first ? 0.f : pr[e]; const float m = (e < 4) ? m0[e & 3] : m1[e & 3]; o[e] = c[e] + m * (pe - c[e]); }
}
struct PrRaw { u32x4 rc[2], rp[2], kc[2], kp[2]; };
__device__ __forceinline__ void pr_load(PrRaw& q, const bf16_t* zr, const bf16_t* zk, size_t g, size_t gp, int h, int fq) {
#pragma unroll
    for (int ks = 0; ks < 2; ++ks) { const int cb = ks * 32 + fq * 8;
        q.rc[ks] = *(const u32x4*)(zr + g * 1024 + h * 64 + cb); q.rp[ks] = *(const u32x4*)(zr + gp * 1024 + h * 64 + cb);
        q.kc[ks] = *(const u32x4*)(zk + g * 1024 + h * 64 + cb); q.kp[ks] = *(const u32x4*)(zk + gp * 1024 + h * 64 + cb); }
}
constexpr int PR_KS = 0, PR_RS = 4352, PR_IC = 8704, PR_EE = 11008, PR_WAVE = 13312;
__device__ void phase_prep(const Params& p, unsigned char* ldsg) {
    const int tid = threadIdx.x, lane = tid & 63, wave = __builtin_amdgcn_readfirstlane(tid >> 6), fr = lane & 15, fq = lane >> 4;
    LAS unsigned char* sc = (LAS unsigned char*)ldsg + wave * PR_WAVE;
    unsigned char* ws = p.ws;
    const bf16_t* zr = (const bf16_t*)(ws + WS_ZR); const bf16_t* zk = (const bf16_t*)(ws + WS_ZK); const bf16_t* zx = (const bf16_t*)(ws + WS_ZX);
    const bf16_t* wupT = (const bf16_t*)(ws + WS_WUP); const bf16_t* aupT = (const bf16_t*)(ws + WS_AUP);
    bf16_t* ICg = (bf16_t*)(ws + WS_IC); bf16_t* EEg = (bf16_t*)(ws + WS_EE); float* INV = (float*)(ws + WS_INVN); float* RK = (float*)(ws + WS_RK);
    const float* mu = p.in[3];
    const int nw = gridDim.x * 8;
    for (int tb = blockIdx.x * 8 + wave; tb < NTOK / 16; tb += nw) {
        const size_t g0 = (size_t)tb * 16, g = g0 + fr; const bool first = ((g & (size_t)(SEQ - 1)) == 0); const size_t gp = first ? g : g - 1;
        bf16x8 Aw[2], Aa[2];
#pragma unroll
        for (int ks = 0; ks < 2; ++ks) {
            const int cb = ks * 32 + fq * 8; float o[8];
            { const u32x4 cv = *(const u32x4*)(zx + g * 256 + cb), pv = *(const u32x4*)(zx + gp * 256 + cb);
              shift8(cv, pv, *(const f32x4*)(mu + 3072 + cb), *(const f32x4*)(mu + 3072 + cb + 4), first, o);
              u32x4 w; w.x = pk2bf(ftanh(o[0]), ftanh(o[1])); w.y = pk2bf(ftanh(o[2]), ftanh(o[3])); w.z = pk2bf(ftanh(o[4]), ftanh(o[5])); w.w = pk2bf(ftanh(o[6]), ftanh(o[7])); Aw[ks] = __builtin_bit_cast(bf16x8, w); }
            { const u32x4 cv = *(const u32x4*)(zx + g * 256 + 64 + cb), pv = *(const u32x4*)(zx + gp * 256 + 64 + cb);
              shift8(cv, pv, *(const f32x4*)(mu + 3136 + cb), *(const f32x4*)(mu + 3136 + cb + 4), first, o);
              u32x4 w; w.x = pk2bf(o[0], o[1]); w.y = pk2bf(o[2], o[3]); w.z = pk2bf(o[4], o[5]); w.w = pk2bf(o[6], o[7]); Aa[ks] = __builtin_bit_cast(bf16x8, w); }
        }
        PrRaw q; pr_load(q, zr, zk, g, gp, 0, fq);
      for (int h = 0; h < 16; ++h) {
        const PrRaw c = q;
        if (h + 1 < 16) pr_load(q, zr, zk, g, gp, h + 1, fq);
#pragma unroll
        for (int ks = 0; ks < 2; ++ks) {
            const int cb = ks * 32 + fq * 8; float o[8];
            { shift8(c.rc[ks], c.rp[ks], *(const f32x4*)(mu + h * 64 + cb), *(const f32x4*)(mu + h * 64 + cb + 4), first, o);
              *(LAS f32x4*)(sc + PR_RS + fr * 272 + cb * 4) = (f32x4){o[0], o[1], o[2], o[3]}; *(LAS f32x4*)(sc + PR_RS + fr * 272 + cb * 4 + 16) = (f32x4){o[4], o[5], o[6], o[7]}; }
            { shift8(c.kc[ks], c.kp[ks], *(const f32x4*)(mu + 1024 + h * 64 + cb), *(const f32x4*)(mu + 1024 + h * 64 + cb + 4), first, o);
              *(LAS f32x4*)(sc + PR_KS + fr * 272 + cb * 4) = (f32x4){o[0], o[1], o[2], o[3]}; *(LAS f32x4*)(sc + PR_KS + fr * 272 + cb * 4 + 16) = (f32x4){o[4], o[5], o[6], o[7]}; }
        }
        wave_lds_sync();
        float ss[4] = {0.f, 0.f, 0.f, 0.f}, rk[4] = {0.f, 0.f, 0.f, 0.f};
#pragma unroll
        for (int nt = 0; nt < 4; ++nt) {
            f32x4 lw = (f32x4){0.f, 0.f, 0.f, 0.f}, la = (f32x4){0.f, 0.f, 0.f, 0.f};
#pragma unroll
            for (int ks = 0; ks < 2; ++ks) {
                const bf16x8 bw = *(const bf16x8*)(wupT + (size_t)(h * 64 + nt * 16 + fr) * 64 + ks * 32 + fq * 8);
                const bf16x8 ba = *(const bf16x8*)(aupT + (size_t)(h * 64 + nt * 16 + fr) * 64 + ks * 32 + fq * 8);
                lw = __builtin_amdgcn_mfma_f32_16x16x32_bf16(Aw[ks], bw, lw, 0, 0, 0);
                la = __builtin_amdgcn_mfma_f32_16x16x32_bf16(Aa[ks], ba, la, 0, 0, 0);
            }
            const int c = nt * 16 + fr, cc = h * 64 + c;
            const float w0c = p.in[4][cc], a0c = p.in[6][cc], kkc = p.in[8][cc], kac = p.in[9][cc], rkc = p.in[10][cc];
#pragma unroll
            for (int j = 0; j < 4; ++j) {
                const int tok = fq * 4 + j;
                const float kraw = *(const LAS float*)(sc + PR_KS + tok * 272 + c * 4), rr = *(const LAS float*)(sc + PR_RS + tok * 272 + c * 4);
                const float ee = 0.6065306597126334f * fsigmoid(w0c + lw[j]);
                const float ic = fsigmoid(a0c + la[j]);
                const float kk = kraw * kkc, kh = kraw * (1.0f + (ic - 1.0f) * kac);
                ss[j] += kk * kk; rk[j] += rr * kh * rkc;
                *(LAS bf16_t*)(sc + PR_IC + tok * 144 + c * 2) = f2bf(ic); *(LAS bf16_t*)(sc + PR_EE + tok * 144 + c * 2) = f2bf(ee);
            }
        }
#pragma unroll
        for (int j = 0; j < 4; ++j) { ss[j] = allred16(ss[j]); rk[j] = allred16(rk[j]); }
        if (fr == 0) {
#pragma unroll
            for (int j = 0; j < 4; ++j) { const size_t gi = (g0 + fq * 4 + j) * 16 + h; INV[gi] = 1.0f / fmaxf(sqrtf(ss[j]), 1e-12f); RK[gi] = rk[j]; }
        }
        wave_lds_sync();
#pragma unroll
        for (int i = 0; i < 2; ++i) { const int piece = lane + i * 64, row = piece >> 3, c8 = (piece & 7) * 8;
            *(u32x4*)(ICg + (g0 + row) * 1024 + h * 64 + c8) = *(const LAS u32x4*)(sc + PR_IC + row * 144 + c8 * 2);
            *(u32x4*)(EEg + (g0 + row) * 1024 + h * 64 + c8) = *(const LAS u32x4*)(sc + PR_EE + row * 144 + c8 * 2); }
        wave_lds_sync();
      }
    }
}

constexpr int WK_OW = 0, WK_OK = 8192, WK_OA = 16384, WK_OB = 24576, WK_OR = 32768, WK_OV = 40960, WK_BUF = 44032;
constexpr int WK_MU = 2 * WK_BUF, WK_PAR = WK_MU + 1088;
struct LdRaw { u32x4 rc, rp, kc, kp, ic, ee, vc, vp; float inv; };
__device__ __forceinline__ void ld_load(LdRaw& q, const unsigned char* ws, int b, int h, int rq, int t, int cg, int vsel) {
    const bf16_t* zr = (const bf16_t*)(ws + WS_ZR); const bf16_t* zk = (const bf16_t*)(ws + WS_ZK); const bf16_t* zv = (const bf16_t*)(ws + WS_ZV);
    const bf16_t* ICg = (const bf16_t*)(ws + WS_IC); const bf16_t* EEg = (const bf16_t*)(ws + WS_EE); const float* INV = (const float*)(ws + WS_INVN);
    const size_t g = (size_t)b * SEQ + t; const size_t gp = (t > 0) ? g - 1 : g;
    q.rc = *(const u32x4*)(zr + g * 1024 + h * 64 + cg); q.rp = *(const u32x4*)(zr + gp * 1024 + h * 64 + cg);
    q.kc = *(const u32x4*)(zk + g * 1024 + h * 64 + cg); q.kp = *(const u32x4*)(zk + gp * 1024 + h * 64 + cg);
    q.ic = *(const u32x4*)(ICg + g * 1024 + h * 64 + cg); q.ee = *(const u32x4*)(EEg + g * 1024 + h * 64 + cg);
    q.vc = *(const u32x4*)(zv + g * 1024 + h * 64 + rq * 16 + vsel * 8); q.vp = *(const u32x4*)(zv + gp * 1024 + h * 64 + rq * 16 + vsel * 8);
    q.inv = INV[g * 16 + h];
}
__device__ __forceinline__ void ld_process(const LdRaw& q, LAS unsigned char* buf, const LAS unsigned char* lds, int tt, int cg, int c7, bool first) {
    const LAS float* MU = (const LAS float*)(lds + WK_MU); const LAS float* PAR = (const LAS float*)(lds + WK_PAR);
    float r[8], k[8], ic[8], ee[8];
    { const f32x4 m0 = *(const LAS f32x4*)(MU + cg), m1 = *(const LAS f32x4*)(MU + cg + 4); shift8(q.rc, q.rp, m0, m1, first, r); }
    { const f32x4 m0 = *(const LAS f32x4*)(MU + 64 + cg), m1 = *(const LAS f32x4*)(MU + 64 + cg + 4); shift8(q.kc, q.kp, m0, m1, first, k); }
    UNPACK8(q.ic, ic); UNPACK8(q.ee, ee);
    const f32x4 kk0 = *(const LAS f32x4*)(PAR + cg), kk1 = *(const LAS f32x4*)(PAR + cg + 4), ka0 = *(const LAS f32x4*)(PAR + 64 + cg), ka1 = *(const LAS f32x4*)(PAR + 64 + cg + 4);
    float w[8], kh[8], a[8], bq[8];
#pragma unroll
    for (int e = 0; e < 8; ++e) { const float kkc = (e < 4) ? kk0[e & 3] : kk1[e & 3], kac = (e < 4) ? ka0[e & 3] : ka1[e & 3];
        kh[e] = k[e] * (1.0f + (ic[e] - 1.0f) * kac); const float kn = k[e] * kkc * q.inv; a[e] = -kn; bq[e] = kn * ic[e];
        w[e] = __builtin_amdgcn_exp2f(ee[e] * -1.4426950408889634f); }
    LAS unsigned char* dst = buf + tt * 256 + c7 * 16;
    *(LAS f32x4*)(dst + WK_OW) = (f32x4){w[0], w[1], w[2], w[3]}; *(LAS f32x4*)(dst + WK_OW + 128) = (f32x4){w[4], w[5], w[6], w[7]};
    *(LAS f32x4*)(dst + WK_OK) = (f32x4){kh[0], kh[1], kh[2], kh[3]}; *(LAS f32x4*)(dst + WK_OK + 128) = (f32x4){kh[4], kh[5], kh[6], kh[7]};
    *(LAS f32x4*)(dst + WK_OA) = (f32x4){a[0], a[1], a[2], a[3]}; *(LAS f32x4*)(dst + WK_OA + 128) = (f32x4){a[4], a[5], a[6], a[7]};
    *(LAS f32x4*)(dst + WK_OB) = (f32x4){bq[0], bq[1], bq[2], bq[3]}; *(LAS f32x4*)(dst + WK_OB + 128) = (f32x4){bq[4], bq[5], bq[6], bq[7]};
    *(LAS f32x4*)(dst + WK_OR) = (f32x4){r[0], r[1], r[2], r[3]}; *(LAS f32x4*)(dst + WK_OR + 128) = (f32x4){r[4], r[5], r[6], r[7]};
    if (c7 < 2) { float v[8]; const f32x4 m0 = *(const LAS f32x4*)(MU + 256 + c7 * 8), m1 = *(const LAS f32x4*)(MU + 256 + c7 * 8 + 4); shift8(q.vc, q.vp, m0, m1, first, v);
#pragma unroll
        for (int e = 0; e < 8; ++e) *(LAS float*)(buf + WK_OV + (c7 * 8 + e) * 128 + tt * 4) = v[e]; }
}
struct WkOps { f32x4 w, k, a, b, r; };
__device__ __forceinline__ WkOps wk_ld(const LAS unsigned char* bb, int tt, int cl, int lrow) {
    WkOps o; const int cs = ((cl >> 1) + 8 * (cl & 1)) * 16;
    o.w = *(const LAS f32x4*)(bb + WK_OW + tt * 256 + cs); o.k = *(const LAS f32x4*)(bb + WK_OK + tt * 256 + cs);
    o.a = *(const LAS f32x4*)(bb + WK_OA + tt * 256 + cs); o.b = *(const LAS f32x4*)(bb + WK_OB + tt * 256 + cs);
    o.r = *(const LAS f32x4*)(bb + WK_OR + tt * 256 + cs);
    return o;
}
__device__ __forceinline__ float wk_step(f32x2& S01, f32x2& S23, const WkOps& o, const float vv) {
    const f32x2 pa = S01 * (f32x2){o.a[0], o.a[1]} + S23 * (f32x2){o.a[2], o.a[3]};
    const float sa = allred16(pa[0] + pa[1]);
    S01 = S01 * (f32x2){o.w[0], o.w[1]} + (f32x2){o.k[0], o.k[1]} * vv;
    S23 = S23 * (f32x2){o.w[2], o.w[3]} + (f32x2){o.k[2], o.k[3]} * vv;
    S01 = S01 + (f32x2){o.b[0], o.b[1]} * sa;
    S23 = S23 + (f32x2){o.b[2], o.b[3]} * sa;
    const f32x2 py = S01 * (f32x2){o.r[0], o.r[1]} + S23 * (f32x2){o.r[2], o.r[3]};
    return py[0] + py[1];
}

__device__ void phase_wkv(const Params& p, unsigned char* ldsg, int vb) {
    LAS unsigned char* lds = (LAS unsigned char*)ldsg;
    const int tid = threadIdx.x, lane = tid & 63, wave = __builtin_amdgcn_readfirstlane(tid >> 6);
    unsigned char* ws = p.ws;
    bf16_t* yraw = (bf16_t*)p.out;
    const float* mu = p.in[3];
    for (int it = vb; it < 256; it += gridDim.x) {
        const int xcd = it & 7, idx = it >> 3, bh = xcd * 8 + (idx >> 2), rq = idx & 3, b = bh >> 4, h = bh & 15;
        __syncthreads();
        if (tid < 272) { float m = 0.f;
            if (tid < 64) m = mu[h * 64 + tid]; else if (tid < 128) m = mu[1024 + h * 64 + tid - 64]; else if (tid >= 256) m = mu[2048 + h * 64 + rq * 16 + tid - 256];
            ((LAS float*)(lds + WK_MU))[tid] = m; }
        if (tid >= 320 && tid < 448) { const int i2 = tid - 320; ((LAS float*)(lds + WK_PAR))[i2] = (i2 < 64) ? p.in[8][h * 64 + i2] : p.in[9][h * 64 + i2 - 64]; }
        __syncthreads();
        const int L = (tid - 256) & 255, ltt = L >> 3, c7 = L & 7, cg = c7 * 8;
        LdRaw q;
        if (wave >= 4) {
            ld_load(q, ws, b, h, rq, ltt, cg, c7 & 1);
            ld_process(q, lds, lds, ltt, cg, c7, ltt == 0);
            ld_load(q, ws, b, h, rq, 32 + ltt, cg, c7 & 1);
        }
        __syncthreads();
        f32x2 S01 = (f32x2){0.f, 0.f}, S23 = (f32x2){0.f, 0.f};
        const int rg = lane >> 4, cl = lane & 15, lrow = (wave & 3) * 4 + rg;
        bf16_t* yout = yraw + ((size_t)b * SEQ + cl) * 1024 + h * 64 + rq * 16 + lrow;
        for (int tile = 0; tile < 256; ++tile) {
            if (wave < 4) {
                const LAS unsigned char* bb = lds + (tile & 1) * WK_BUF;
                WkOps o0 = wk_ld(bb, 0, cl, lrow), o1 = wk_ld(bb, 1, cl, lrow);
                f32x4 vcur = *(const LAS f32x4*)(bb + WK_OV + lrow * 128), vnx = vcur;
#pragma unroll
                for (int hlf = 0; hlf < 2; ++hlf) {
                    float yp[16];
#pragma unroll
                    for (int i = 0; i < 16; i += 2) {
                        const int tt = hlf * 16 + i;
                        if ((tt & 3) == 0 && tt + 4 < 32) vnx = *(const LAS f32x4*)(bb + WK_OV + lrow * 128 + (tt + 4) * 4);
                        const WkOps o2 = wk_ld(bb, (tt + 2 < 32) ? tt + 2 : 31, cl, lrow);
                        __builtin_amdgcn_sched_barrier(0x11);
                        yp[i] = wk_step(S01, S23, o0, vcur[tt & 3]);
                        const WkOps o3 = wk_ld(bb, (tt + 3 < 32) ? tt + 3 : 31, cl, lrow);
                        __builtin_amdgcn_sched_barrier(0x11);
                        yp[i + 1] = wk_step(S01, S23, o1, vcur[(tt + 1) & 3]);
                        if ((tt & 3) == 2) vcur = vnx;
                        o0 = o2; o1 = o3;
                    }
#pragma unroll
                    for (int i = 0; i < 8; ++i) { const float keep = (cl & 8) ? yp[i + 8] : yp[i], send = (cl & 8) ? yp[i] : yp[i + 8]; yp[i] = keep + dppf<0x128>(send); }
#pragma unroll
                    for (int i = 0; i < 4; ++i) { const float keep = (cl & 4) ? yp[i + 4] : yp[i], send = (cl & 4) ? yp[i] : yp[i + 4]; yp[i] = keep + dppf<0x141>(send); }
#pragma unroll
                    for (int i = 0; i < 2; ++i) { const float keep = (cl & 2) ? yp[i + 2] : yp[i], send = (cl & 2) ? yp[i] : yp[i + 2]; yp[i] = keep + dppf<0x4E>(send); }
                    { const float keep = (cl & 1) ? yp[1] : yp[0], send = (cl & 1) ? yp[0] : yp[1]; yp[0] = keep + dppf<0xB1>(send); }
                    yout[(size_t)(tile * 32 + hlf * 16) * 1024] = f2bf(yp[0]);
                }
            } else if (tile + 1 < 256) {
                ld_process(q, lds + ((tile + 1) & 1) * WK_BUF, lds, ltt, cg, c7, false);
                if (tile + 2 < 256) ld_load(q, ws, b, h, rq, (tile + 2) * 32 + ltt, cg, c7 & 1);
            }
            __syncthreads();
        }
    }
}

typedef short bf16x4 __attribute__((ext_vector_type(4)));
template <bool OUT>
__device__ void phase_s5(const Params& p, unsigned char* ldsg) {
    LAS unsigned char* lds = (LAS unsigned char*)ldsg;
    const int tid = threadIdx.x, lane = tid & 63, wave = __builtin_amdgcn_readfirstlane(tid >> 6);
    unsigned char* ws = p.ws;
    LAS unsigned char* BUT = lds + wave * 14592;
    LAS unsigned char* SS = lds + wave * 14592 + 10240;
    const bf16_t* zu = (const bf16_t*)(ws + WS_ZU); bf16_t* ysg = (bf16_t*)((unsigned char*)p.out + OUT_YSG);
    const bf16_t* bbt = (const bf16_t*)(ws + WS_S5C + S5_BBRE);
    const int fr = lane & 15, fq = lane >> 4;
    for (int item = blockIdx.x; item < 512; item += gridDim.x) {
        const int b = item >> 7, c = (item >> 2) & 31, gq = item & 3, g = gq * 8 + wave;
        const f32x2 ab = ((const f32x2*)(ws + WS_S5C + S5_AB))[g * 64 + lane];
        bf16x4 bbf[8];
#pragma unroll
        for (int nt = 0; nt < 8; ++nt) bbf[nt] = *(const bf16x4*)(bbt + ((size_t)(g * 128 + nt * 16 + fr) * 16 + fq * 4));
        float sre = 0.f, sim = 0.f;
        bf16x8 cmf[4]; float dsk = 0.f;
        if (OUT) { const f32x2 ap = ((const f32x2*)(ws + WS_S5C + S5_APOW))[g * 64 + lane];
            const f32x2* sl = (const f32x2*)(ws + WS_SLOC) + (size_t)(b * 32 + g) * 32 * 64 + lane;
            for (int cc0 = 0; cc0 < c; cc0 += 8) {
                f32x2 e[8];
#pragma unroll
                for (int i = 0; i < 8; ++i) e[i] = (cc0 + i < c) ? sl[(cc0 + i) * 64] : (f32x2){0.f, 0.f};
#pragma unroll
                for (int i = 0; i < 8; ++i) if (cc0 + i < c) { const float nr = ap[0] * sre - ap[1] * sim + e[i][0], ni = ap[0] * sim + ap[1] * sre + e[i][1]; sre = nr; sim = ni; }
            }
#pragma unroll
            for (int ks = 0; ks < 4; ++ks) cmf[ks] = *(const bf16x8*)((const bf16_t*)(ws + WS_S5C + S5_CMT) + (size_t)(g * 16 + fr) * 128 + ks * 32 + fq * 8);
            dsk = p.in[20][g * 16 + fr]; }
        const size_t tok0 = (size_t)b * SEQ + (size_t)c * 256;
        if (!OUT) {
            f32x2 lam[4], l16[4], wq[4], T[4];
#pragma unroll
            for (int k = 0; k < 4; ++k) {
                const f32x2 l1 = ((const f32x2*)(ws + WS_S5C + S5_AB))[g * 64 + fr + 16 * k];
                const f32x2 l2 = (f32x2){l1[0] * l1[0] - l1[1] * l1[1], 2.f * l1[0] * l1[1]};
                const f32x2 l4 = (f32x2){l2[0] * l2[0] - l2[1] * l2[1], 2.f * l2[0] * l2[1]};
                const f32x2 l8 = (f32x2){l4[0] * l4[0] - l4[1] * l4[1], 2.f * l4[0] * l4[1]};
                const f32x2 l12 = (f32x2){l8[0] * l4[0] - l8[1] * l4[1], l8[0] * l4[1] + l8[1] * l4[0]};
                lam[k] = l1; l16[k] = (f32x2){l8[0] * l8[0] - l8[1] * l8[1], 2.f * l8[0] * l8[1]};
                wq[k] = (fq == 3) ? (f32x2){1.f, 0.f} : (fq == 2) ? l4 : (fq == 1) ? l8 : l12;
                T[k] = (f32x2){0.f, 0.f};
            }
            bf16x4 aq = *(const bf16x4*)(zu + (tok0 + fr) * 512 + g * 16 + fq * 4);
            for (int st = 0; st < 16; ++st) {
                const bf16x4 acur = aq;
                if (st + 1 < 16) aq = *(const bf16x4*)(zu + (tok0 + (st + 1) * 16 + fr) * 512 + g * 16 + fq * 4);
                f32x4 d[8];
#pragma unroll
                for (int nt = 0; nt < 8; ++nt) d[nt] = __builtin_amdgcn_mfma_f32_16x16x16bf16_1k(acur, bbf[nt], (f32x4){0.f, 0.f, 0.f, 0.f}, 0, 0, 0);
#pragma unroll
                for (int k = 0; k < 4; ++k) {
                    float xr = d[k][0], xi = d[4 + k][0];
#pragma unroll
                    for (int j = 1; j < 4; ++j) { const float nr = lam[k][0] * xr - lam[k][1] * xi + d[k][j], ni = lam[k][0] * xi + lam[k][1] * xr + d[4 + k][j]; xr = nr; xi = ni; }
                    const float tr = l16[k][0] * T[k][0] - l16[k][1] * T[k][1] + xr, ti = l16[k][0] * T[k][1] + l16[k][1] * T[k][0] + xi;
                    T[k] = (f32x2){tr, ti};
                }
            }
            float outr = 0.f, outi = 0.f;
#pragma unroll
            for (int k = 0; k < 4; ++k) {
                float cr = wq[k][0] * T[k][0] - wq[k][1] * T[k][1], ci = wq[k][0] * T[k][1] + wq[k][1] * T[k][0];
                cr += __shfl_xor(cr, 16); cr += __shfl_xor(cr, 32); ci += __shfl_xor(ci, 16); ci += __shfl_xor(ci, 32);
                if (fq == k) { outr = cr; outi = ci; }
            }
            ((f32x2*)(ws + WS_SLOC))[((size_t)(b * 32 + g) * 32 + c) * 64 + fr + 16 * fq] = (f32x2){outr, outi};
            continue;
        }
        bf16x4 au = *(const bf16x4*)(zu + (tok0 + fr) * 512 + g * 16 + fq * 4);
        for (int st = 0; st < 16; ++st) {
            const size_t tb = tok0 + st * 16;
            const bf16x4 acur = au;
            unsigned short uraw[4];
            if (OUT) {
#pragma unroll
                for (int j = 0; j < 4; ++j) uraw[j] = zu[(tb + fq * 4 + j) * 512 + g * 16 + fr];
            }
            if (st + 1 < 16) au = *(const bf16x4*)(zu + (tb + 16 + fr) * 512 + g * 16 + fq * 4);
#pragma unroll
            for (int nt = 0; nt < 8; ++nt) {
                const f32x4 d = __builtin_amdgcn_mfma_f32_16x16x16bf16_1k(acur, bbf[nt], (f32x4){0.f, 0.f, 0.f, 0.f}, 0, 0, 0);
                *(LAS f32x4*)(BUT + (nt * 16 + fr) * 80 + fq * 16) = d;
            }
            wave_lds_sync();
            f32x4 bre[4], bim[4];
#pragma unroll
            for (int q4 = 0; q4 < 4; ++q4) { bre[q4] = *(const LAS f32x4*)(BUT + lane * 80 + q4 * 16); bim[q4] = *(const LAS f32x4*)(BUT + (64 + lane) * 80 + q4 * 16); }
#pragma unroll
            for (int tt = 0; tt < 16; ++tt) {
                const float bur = bre[tt >> 2][tt & 3], bui = bim[tt >> 2][tt & 3];
                const float nre = ab[0] * sre - ab[1] * sim + bur, nim = ab[0] * sim + ab[1] * sre + bui;
                sre = nre; sim = nim;
                if (OUT) *(LAS unsigned*)(SS + tt * 272 + lane * 4) = pk2bf(sre, sim);
            }
            if (OUT) {
                wave_lds_sync();
                f32x4 acc = (f32x4){0.f, 0.f, 0.f, 0.f};
#pragma unroll
                for (int ks = 0; ks < 4; ++ks) { const bf16x8 a = *(const LAS bf16x8*)(SS + fr * 272 + (ks * 32 + fq * 8) * 2); acc = __builtin_amdgcn_mfma_f32_16x16x32_bf16(a, cmf[ks], acc, 0, 0, 0); }
#pragma unroll
                for (int j = 0; j < 4; ++j) ysg[(tb + fq * 4 + j) * 512 + g * 16 + fr] = f2bf(fgelu_tanh(acc[j] + dsk * bf2f(uraw[j])));
            }
            wave_lds_sync();
        }
        if (!OUT) ((f32x2*)(ws + WS_SLOC))[((size_t)(b * 32 + g) * 32 + c) * 64 + lane] = (f32x2){sre, sim};
    }
}
__device__ void phase_s5_carry(const Params& p) {
    unsigned char* ws = p.ws;
    const int gid = blockIdx.x * 512 + threadIdx.x;
    if (gid < 8192) {
        const int b = gid >> 11, g = (gid >> 6) & 31, pp = gid & 63;
        const f32x2 ap = ((const f32x2*)(ws + WS_S5C + S5_APOW))[g * 64 + pp];
        const f32x2* sl = (const f32x2*)(ws + WS_SLOC) + (size_t)(b * 32 + g) * 32 * 64 + pp; f32x2* st = (f32x2*)(ws + WS_SSTART) + (size_t)(b * 32 + g) * 32 * 64 + pp;
        float cr = 0.f, ci = 0.f;
#pragma unroll 8
        for (int c = 0; c < 32; ++c) { st[c * 64] = (f32x2){cr, ci}; const f32x2 e = sl[c * 64];
            const float nr = ap[0] * cr - ap[1] * ci + e[0], ni = ap[0] * ci + ap[1] * cr + e[1]; cr = nr; ci = ni; }
    }
}

struct YaRaw { u32x4 y0, y1, a0, a1, b0, b1, g0, g1; float rk; };
__device__ __forceinline__ void ya_load(YaRaw& q, const bf16_t* yraw, const bf16_t* zv, const bf16_t* zga, const float* rkb, int row, int c0, int hh) {
    const bool first = (row & (SEQ - 1)) == 0; const size_t ro = (size_t)row * 1024 + c0; const size_t rp = first ? ro : ro - 1024;
    q.y0 = *(const u32x4*)(yraw + ro); q.y1 = *(const u32x4*)(yraw + ro + 8);
    q.a0 = *(const u32x4*)(zv + ro); q.a1 = *(const u32x4*)(zv + ro + 8); q.b0 = *(const u32x4*)(zv + rp); q.b1 = *(const u32x4*)(zv + rp + 8);
    q.g0 = *(const u32x4*)(zga + ro); q.g1 = *(const u32x4*)(zga + ro + 8); q.rk = rkb[(size_t)row * 16 + hh];
}
__device__ void phase_ya(const Params& p) {
    const int tid = threadIdx.x, lane = tid & 63, wave = tid >> 6;
    unsigned char* ws = p.ws;
    const bf16_t* yraw = (const bf16_t*)p.out; const float* rkb = (const float*)(ws + WS_RK);
    const bf16_t* zv = (const bf16_t*)(ws + WS_ZV); const bf16_t* zga = (const bf16_t*)(ws + WS_ZGA); bf16_t* ya = (bf16_t*)(ws + WS_YA);
    const int c0 = lane * 16, hh = lane >> 2;
    float lg[16], lb[16], mv[16];
#pragma unroll
    for (int i = 0; i < 4; ++i) { const f32x4 a = *(const f32x4*)(p.in[11] + c0 + i * 4), bq = *(const f32x4*)(p.in[12] + c0 + i * 4), m = *(const f32x4*)(p.in[3] + 2048 + c0 + i * 4);
#pragma unroll
        for (int e = 0; e < 4; ++e) { lg[i * 4 + e] = a[e]; lb[i * 4 + e] = bq[e]; mv[i * 4 + e] = m[e]; } }
    YaRaw q;
    { const int row = blockIdx.x * 8 + wave; if (row < NTOK) ya_load(q, yraw, zv, zga, rkb, row, c0, hh); }
    for (int row = blockIdx.x * 8 + wave; row < NTOK; row += gridDim.x * 8) {
        const bool first = (row & (SEQ - 1)) == 0; const size_t ro = (size_t)row * 1024 + c0;
        const YaRaw c = q;
        if (row + (int)gridDim.x * 8 < NTOK) ya_load(q, yraw, zv, zga, rkb, row + (int)gridDim.x * 8, c0, hh);
        float y[16];
        UNPACK8(c.y0, y); UNPACK8(c.y1, y + 8);
        float s = 0.f;
#pragma unroll
        for (int e = 0; e < 16; ++e) s += y[e];
        const float mean = allred4(s) * (1.0f / 64.0f);
        float s2 = 0.f;
#pragma unroll
        for (int e = 0; e < 16; ++e) { const float d = y[e] - mean; s2 += d * d; }
        const float rstd = rsqrtf(allred4(s2) * (1.0f / 64.0f) + 64e-5f);
        const float rk = c.rk;
        float vc[16], vp[16], ga[16];
        UNPACK8(c.a0, vc); UNPACK8(c.a1, vc + 8); UNPACK8(c.b0, vp); UNPACK8(c.b1, vp + 8); UNPACK8(c.g0, ga); UNPACK8(c.g1, ga + 8);
        float o[16];
#pragma unroll
        for (int e = 0; e < 16; ++e) { const float pv = first ? 0.f : vp[e]; const float v = vc[e] + mv[e] * (pv - vc[e]);
            const float yn = (y[e] - mean) * rstd * lg[e] + lb[e] + rk * v; o[e] = yn * ga[e] * fsigmoid(ga[e]); }
        u32x4 w0, w1; w0.x = pk2bf(o[0], o[1]); w0.y = pk2bf(o[2], o[3]); w0.z = pk2bf(o[4], o[5]); w0.w = pk2bf(o[6], o[7]);
        w1.x = pk2bf(o[8], o[9]); w1.y = pk2bf(o[10], o[11]); w1.z = pk2bf(o[12], o[13]); w1.w = pk2bf(o[14], o[15]);
        *(u32x4*)(ya + ro) = w0; *(u32x4*)(ya + ro + 8) = w1;
    }
}

struct FnRaw { f32x4 x0, x1, x2, x3; u32x4 o0, o1; };
__device__ __forceinline__ void fn_load(FnRaw& q, const float* x, const bf16_t* ob, int row, int lane) {
    const float* xp = x + (size_t)row * 1024 + lane * 16; const bf16_t* op = ob + (size_t)row * 1024 + lane * 16;
    q.x0 = *(const f32x4*)(xp); q.x1 = *(const f32x4*)(xp + 4); q.x2 = *(const f32x4*)(xp + 8); q.x3 = *(const f32x4*)(xp + 12);
    q.o0 = *(const u32x4*)(op); q.o1 = *(const u32x4*)(op + 8);
}
__device__ void phase_final_norm(const Params& p) {
    const int tid = threadIdx.x, lane = tid & 63, wave = tid >> 6;
    float* out = p.out; const float* fg = p.in[26]; const float* x = p.in[0]; const bf16_t* ob = (const bf16_t*)(p.ws + WS_OB);
    f32x4 gv[4];
#pragma unroll
    for (int i = 0; i < 4; ++i) gv[i] = *(const f32x4*)(fg + lane * 16 + i * 4);
    const int rstep = (int)gridDim.x * 8;
    FnRaw q;
    { const int row = blockIdx.x * 8 + wave; if (row < NTOK) fn_load(q, x, ob, row, lane); }
    for (int row = blockIdx.x * 8 + wave; row < NTOK; row += rstep) {
        const FnRaw c = q;
        if (row + rstep < NTOK) fn_load(q, x, ob, row + rstep, lane);
        float o[16]; UNPACK8(c.o0, o); UNPACK8(c.o1, o + 8);
        f32x4 v[4];
        v[0] = c.x0 + (f32x4){o[0], o[1], o[2], o[3]}; v[1] = c.x1 + (f32x4){o[4], o[5], o[6], o[7]};
        v[2] = c.x2 + (f32x4){o[8], o[9], o[10], o[11]}; v[3] = c.x3 + (f32x4){o[12], o[13], o[14], o[15]};
        float ss = 0.f;
#pragma unroll
        for (int i = 0; i < 4; ++i) ss += v[i][0] * v[i][0] + v[i][1] * v[i][1] + v[i][2] * v[i][2] + v[i][3] * v[i][3];
        ss = allred64(ss);
        const float rs = rsqrtf(ss * (1.0f / 1024.0f) + 1e-6f);
#pragma unroll
        for (int i = 0; i < 4; ++i) *(f32x4*)(out + (size_t)row * 1024 + lane * 16 + i * 4) = v[i] * gv[i] * rs;
    }
}

#define XB_TMO      128
#define XB_XCNT(j)  (256  + 64 * (j))
#define XB_XSUB(j)  (1280 + 64 * (j))
#define XB_XGEN(j)  (2304 + 64 * (j))
#define XB_TOP      3328
#define XB_TOPGEN   3392
#define XCD_BAR_WORDS 3456
#define XB_SPIN_CAP (1u << 18)
__device__ __forceinline__ unsigned xb_ld(unsigned* p)              { return __hip_atomic_load(p, __ATOMIC_RELAXED, __HIP_MEMORY_SCOPE_AGENT); }
__device__ __forceinline__ unsigned xb_add(unsigned* p, unsigned v) { return __hip_atomic_fetch_add(p, v, __ATOMIC_RELAXED, __HIP_MEMORY_SCOPE_AGENT); }
__device__ __forceinline__ unsigned xb_xcc_id() { return (unsigned)__builtin_amdgcn_s_getreg((3 << 11) | 20) & 0xFu; }
#define XB_SPIN(cond, bar) do { unsigned _sp = 0; while (cond) { __builtin_amdgcn_s_sleep(1); \
    if ((++_sp & 255u) == 0u) { if (xb_ld(&(bar)[XB_TMO])) break; if (_sp > XB_SPIN_CAP) { atomicAdd(&(bar)[XB_TMO], 1u); break; } } } } while (0)
struct XcdBarrier { unsigned* bar; unsigned x; volatile LAS unsigned* st; };
__device__ __forceinline__ XcdBarrier xcd_barrier_post(unsigned* bar, volatile LAS unsigned* st) {
    XcdBarrier b; b.bar = bar; b.x = xb_xcc_id(); b.st = st;
    if (threadIdx.x == 0) { st[2] = xb_add(&bar[XB_XCNT(b.x)], 1u); st[3] = b.x; }
    return b;
}
__device__ __forceinline__ void xcd_barrier_complete(unsigned* bar, unsigned x, unsigned& nloc, unsigned& nx) {
    const unsigned G = gridDim.x * gridDim.y * gridDim.z;
    unsigned sum, cnt, mine, sp = 0u;
    for (;;) {
        sum = 0u; cnt = 0u; mine = 0u;
#pragma unroll
        for (unsigned j = 0; j < 16; ++j) { const unsigned c = xb_ld(&bar[XB_XCNT(j)]); sum += c; cnt += (c > 0u) ? 1u : 0u; mine = (j == x) ? c : mine; }
        if (sum == G) break;
        __builtin_amdgcn_s_sleep(1);
        if ((++sp & 255u) == 0u) { if (xb_ld(&bar[XB_TMO])) break; if (sp > XB_SPIN_CAP) { atomicAdd(&bar[XB_TMO], 1u); break; } }
    }
    nloc = mine > 0u ? mine : 1u; nx = cnt > 0u ? cnt : 1u;
}
__device__ __forceinline__ void xcd_barrier(const XcdBarrier& b) {
    asm volatile("s_waitcnt vmcnt(0)" ::: "memory");
    __syncthreads();
    if (threadIdx.x == 0) {
        unsigned* bar = b.bar;
        __builtin_amdgcn_s_waitcnt(0);
        unsigned nloc = b.st[0], nx = b.st[1];
        if (nloc == 0u) { xcd_barrier_complete(bar, b.x, nloc, nx); b.st[0] = nloc; b.st[1] = nx; }
        const unsigned old = xb_add(&bar[XB_XSUB(b.x)], 1u);
        const unsigned gen = old / nloc;
        if (old + 1u == (gen + 1u) * nloc) {
            __builtin_amdgcn_fence(__ATOMIC_RELEASE, "agent");
            asm volatile("s_waitcnt vmcnt(0)" ::: "memory");
            const unsigned og = xb_add(&bar[XB_TOP], 1u);
            const unsigned tg = og / nx;
            if (og + 1u == (tg + 1u) * nx) xb_add(&bar[XB_TOPGEN], 1u);
            else XB_SPIN(xb_ld(&bar[XB_TOPGEN]) == tg, bar);
            __builtin_amdgcn_fence(__ATOMIC_ACQUIRE, "agent");
            xb_add(&bar[XB_XGEN(b.x)], 1u);
            asm volatile("s_waitcnt vmcnt(0)" ::: "memory");
        } else {
            XB_SPIN(xb_ld(&bar[XB_XGEN(b.x)]) == gen, bar);
            __builtin_amdgcn_fence(__ATOMIC_ACQUIRE, "agent");
            asm volatile("s_waitcnt vmcnt(0)" ::: "memory");
        }
    }
    __syncthreads();
}

__global__ void __launch_bounds__(512, 2) mega_fwd(Params p) {
    extern __shared__ __attribute__((aligned(16))) unsigned char lds[];
    unsigned char* ws = p.ws;
    volatile LAS unsigned* xst = (volatile LAS unsigned*)((LAS unsigned char*)lds + 131072);
    if (threadIdx.x < 8) xst[threadIdx.x] = 0u;
    __syncthreads();
    XcdBarrier xbar = xcd_barrier_post((unsigned*)ws, xst);
#ifndef PHASE_MASK
#define PHASE_MASK 0xfff
#endif
#define PH_ON(n) ((PHASE_MASK >> (n)) & 1)
#ifndef REPEAT_MASK
#define REPEAT_MASK 0
#endif
#define PH_BEGIN(n) if (PH_ON(n) && p.ph_lo <= (n) && (n) < p.ph_hi) { for (int _r = 0; _r <= ((REPEAT_MASK >> (n)) & 1); ++_r) {
#define PH_END(n) } if ((n) + 1 < p.ph_hi) { xcd_barrier(xbar); } }
    unsigned char* ob = (unsigned char*)p.out;
    if (p.ph_lo < 0) cg::this_grid().sync();
    PH_BEGIN(0) phase_prologue(p, lds); PH_END(0)
    int vb = (int)blockIdx.x;
    if (p.ph_hi - p.ph_lo > 1) {
        if (threadIdx.x == 0) { unsigned okc = ((gridDim.x & 7u) == 0u) ? 1u : 0u;
            for (unsigned j = 0; j < 16; ++j) { const unsigned cnt = xb_ld((unsigned*)ws + XB_XCNT(j)); if (cnt != ((j < 8) ? gridDim.x / 8u : 0u)) okc = 0u; }
            xst[1 + 4] = okc; }
        __syncthreads();
        if (xst[5] != 0u) vb = (int)(xst[2] * 8u + xst[3]);
        __syncthreads();
    }
    PH_BEGIN(1) { pg8::StaticOrder S; pg8::Gemm g{(const bf16_t*)p.out, (const bf16_t*)(ws + WS_WIN), NTOK, INWP, 1024}; S.init(g.M, g.N, (int)gridDim.x, vb);
                  EpiZ E{ws}; pg8::gemm_phase((LAS unsigned char*)lds, g, S, E); } PH_END(1)
    PH_BEGIN(2) phase_s5<false>(p, lds); PH_END(2)
    PH_BEGIN(3) phase_s5<true>(p, lds); PH_END(3)
    PH_BEGIN(4) { pg8::StaticOrder S; pg8::Gemm g{(const bf16_t*)(ob + OUT_YSG), (const bf16_t*)(ws + WS_WGLU), NTOK, 1024, 512}; S.init(g.M, g.N, (int)gridDim.x, vb);
                  EpiGlu E{ws, p.in[22], (bf16_t*)(ob + OUT_YB)}; pg8::gemm_phase((LAS unsigned char*)lds, g, S, E); } PH_END(4)
    PH_BEGIN(5) { pg8::StaticOrder S; pg8::Gemm g{(const bf16_t*)(ob + OUT_YB), (const bf16_t*)(ws + WS_WPB), NTOK, 1024, 512}; S.init(g.M, g.N, (int)gridDim.x, vb);
                  EpiGate<0> E{(const bf16_t*)(ws + WS_ZMB), nullptr, (bf16_t*)(ob + OUT_MB)}; pg8::gemm_phase((LAS unsigned char*)lds, g, S, E); } PH_END(5)
    PH_BEGIN(6) phase_prep(p, lds); PH_END(6)
    PH_BEGIN(7) phase_wkv(p, lds, vb); PH_END(7)
    PH_BEGIN(8) phase_ya(p); PH_END(8)
    PH_BEGIN(9) { pg8::StaticOrder S; pg8::Gemm g{(const bf16_t*)(ws + WS_YA), (const bf16_t*)(ws + WS_WPA), NTOK, 1024, 1024}; S.init(g.M, g.N, (int)gridDim.x, vb);
                  EpiGate<1> E{(const bf16_t*)(ws + WS_ZMA), (const bf16_t*)(ob + OUT_MB), (bf16_t*)(ws + WS_MERGED)}; pg8::gemm_phase((LAS unsigned char*)lds, g, S, E); } PH_END(9)
    PH_BEGIN(10) { pg8::StaticOrder S; pg8::Gemm g{(const bf16_t*)(ws + WS_MERGED), (const bf16_t*)(ws + WS_WOUT), NTOK, 1024, 1024}; S.init(g.M, g.N, (int)gridDim.x, vb);
                  EpiOut E{(bf16_t*)(ws + WS_OB)}; pg8::gemm_phase((LAS unsigned char*)lds, g, S, E); } PH_END(10)
#ifdef EXTRA_SYNCS
    for (int _e = 0; _e < EXTRA_SYNCS; ++_e) cg::this_grid().sync();
#endif
    PH_BEGIN(11) phase_final_norm(p); PH_END(11)
}

extern "C" void kernel_launch(void* const* d_in, const int* in_sizes, int n_in, void* d_out, int out_size, void* d_ws, size_t ws_size, hipStream_t stream) {
    static int grid = 0;
    if (grid == 0) {
        if (n_in != 27 || out_size != NTOK * DM || ws_size < WS_END) { fprintf(stderr, "kernel_launch: unexpected sizes (n_in %d out %d ws %zu, need %zu)\n", n_in, out_size, ws_size, (size_t)WS_END); grid = -1; return; }
        int dev = 0, cus = 0, per_cu = 0;
        (void)hipGetDevice(&dev); (void)hipDeviceGetAttribute(&cus, hipDeviceAttributeMultiprocessorCount, dev);
        if (hipFuncSetAttribute((const void*)mega_fwd, hipFuncAttributeMaxDynamicSharedMemorySize, LDS_BYTES) != hipSuccess) { fprintf(stderr, "kernel_launch: hipFuncSetAttribute failed\n"); grid = -1; return; }
        if (hipOccupancyMaxActiveBlocksPerMultiprocessor(&per_cu, (const void*)mega_fwd, 512, LDS_BYTES) != hipSuccess || per_cu < 1) { fprintf(stderr, "kernel_launch: occupancy query says %d blocks/CU\n", per_cu); per_cu = 1; }
        (void)hipGetLastError();
        grid = cus > 0 ? cus : 256;
    }
    if (grid < 0) return;
    if (hipMemsetAsync(d_ws, 0, XCD_BAR_WORDS * 4, stream) != hipSuccess) { fprintf(stderr, "kernel_launch: memset failed\n"); return; }
    Params p{};
    for (int i = 0; i < 27; ++i) p.in[i] = (const float*)d_in[i];
    p.out = (float*)d_out; p.ws = (unsigned char*)d_ws;
#if MK_MULTI
    for (int ph = 0; ph < NPHASE; ++ph) { p.ph_lo = ph; p.ph_hi = ph + 1; hipLaunchKernelGGL(mega_fwd, dim3(grid), dim3(512), LDS_BYTES, stream, p); }
#else
    p.ph_lo = 0; p.ph_hi = NPHASE;
    void* args[] = {&p};
    hipError_t e = hipLaunchCooperativeKernel((const void*)mega_fwd, dim3(grid), dim3(512), args, LDS_BYTES, stream);
    if (e != hipSuccess) fprintf(stderr, "kernel_launch: cooperative launch failed: %s (grid %d)\n", hipGetErrorString(e), grid);
#endif
}
```

```cpp
#include <hip/hip_runtime.h>
#include <hip/hip_cooperative_groups.h>
#include <cstdio>
#include <cstdint>
namespace cg = cooperative_groups;

#ifndef MK_MULTI
#define MK_MULTI 0
#endif

#define LAS __attribute__((address_space(3)))
typedef unsigned short bf16_t;
typedef short bf16x8 __attribute__((ext_vector_type(8)));
typedef float f32x4 __attribute__((ext_vector_type(4)));
typedef float f32x2 __attribute__((ext_vector_type(2)));
typedef unsigned u32x4 __attribute__((ext_vector_type(4)));
typedef unsigned u32x2 __attribute__((ext_vector_type(2)));

constexpr int DM = 1024, NBATCH = 4, SEQ = 8192, NTOK = NBATCH * SEQ;
constexpr int INW = 7296, INWP = 7424;
constexpr size_t MiB = (size_t)1 << 20;
constexpr size_t WS_ZR = 1 * MiB, WS_ZK = 65 * MiB, WS_ZV = 129 * MiB, WS_ZGA = 193 * MiB, WS_ZU = 257 * MiB, WS_ZGB = 289 * MiB,
                 WS_ZMA = 321 * MiB, WS_ZMB = 385 * MiB, WS_ZX = 449 * MiB;
constexpr size_t WS_WIN = 465 * MiB, WS_WGLU = 480 * MiB, WS_WPA = 481 * MiB, WS_WPB = 483 * MiB, WS_WOUT = 484 * MiB, WS_WUP = 486 * MiB,
                 WS_AUP = 486 * MiB + 256 * 1024, WS_RK = 487 * MiB, WS_SLOC = 489 * MiB, WS_SSTART = 491 * MiB, WS_S5C = 493 * MiB, WS_ZX2 = 494 * MiB  , WS_END = 510 * MiB;
constexpr size_t S5_AB = 0, S5_APOW = 16384, S5_BBRE = 32768, S5_BBIM = 32768 + 131072, S5_CMT = 32768 + 262144  ;
constexpr size_t WS_IC = WS_ZU;
constexpr size_t WS_EE = WS_ZMB;
constexpr size_t WS_INVN = WS_SLOC;
constexpr size_t WS_YA = WS_ZR;
constexpr size_t WS_OB = WS_ZV;
constexpr size_t WS_MERGED = WS_ZK;
constexpr size_t OUT_YSG = 0, OUT_YB = 32 * MiB, OUT_MB = 64 * MiB;
constexpr int LDS_BYTES = 131072 + 32;
constexpr int NPHASE = 12;

struct Params { const float* in[27]; float* out; unsigned char* ws; int ph_lo, ph_hi; };

__device__ __forceinline__ unsigned pk2bf(float lo, float hi) { unsigned r; asm volatile("v_cvt_pk_bf16_f32 %0, %1, %2" : "=v"(r) : "v"(lo), "v"(hi)); return r; }
__device__ __forceinline__ bf16_t f2bf(float f) { return (bf16_t)(pk2bf(f, 0.f) & 0xffffu); }
__device__ __forceinline__ float bf2f(bf16_t v) { return __uint_as_float(((unsigned)v) << 16); }
__device__ __forceinline__ float bflo(unsigned w) { return __uint_as_float(w << 16); }
__device__ __forceinline__ float bfhi(unsigned w) { return __uint_as_float(w & 0xffff0000u); }
#define UNPACK8(v, f) do { (f)[0] = bflo((v).x); (f)[1] = bfhi((v).x); (f)[2] = bflo((v).y); (f)[3] = bfhi((v).y); (f)[4] = bflo((v).z); (f)[5] = bfhi((v).z); (f)[6] = bflo((v).w); (f)[7] = bfhi((v).w); } while (0)
__device__ __forceinline__ float fsigmoid(float x) { return __builtin_amdgcn_rcpf(1.0f + __expf(-x)); }
__device__ __forceinline__ float ftanh(float x) { const float t = __expf(2.0f * x); return 1.0f - 2.0f * __builtin_amdgcn_rcpf(t + 1.0f); }
__device__ __forceinline__ float fgelu_tanh(float x) { return 0.5f * x * (1.0f + ftanh(0.7978845608028654f * (x + 0.044715f * x * x * x))); }
template <int CTRL> __device__ __forceinline__ float dppf(float v) { return __int_as_float(__builtin_amdgcn_update_dpp(0, __float_as_int(v), CTRL, 0xf, 0xf, true)); }
__device__ __forceinline__ float allred16(float p) { p += dppf<0xB1>(p); p += dppf<0x4E>(p); p += dppf<0x124>(p); p += dppf<0x128>(p); return p; }
__device__ __forceinline__ float allred4(float p) { p += dppf<0xB1>(p); p += dppf<0x4E>(p); return p; }
__device__ __forceinline__ float allred64(float p) { p = allred16(p); p += __shfl_xor(p, 16); p += __shfl_xor(p, 32); return p; }
__device__ __forceinline__ void wave_lds_sync() { asm volatile("s_waitcnt lgkmcnt(0)" ::: "memory"); __builtin_amdgcn_wave_barrier(); asm volatile("" ::: "memory"); }

namespace pg8 {
constexpr int BM = 256, BK = 64, HALF = 128, HTB = HALF * BK * 2, STAGE_BYTES = 8 * HTB, NXCD = 8, WGM = 8;
__host__ __device__ __forceinline__ int lds_byte(int r, int c) { const int st = (r >> 4) * 2 + (c >> 5), rr = r & 15, cc = c & 31, ob = rr * 64 + cc * 2; return st * 1024 + (ob ^ (((ob >> 9) & 1) << 5)); }
__host__ __device__ __forceinline__ void stage_rc(int b, int& R, int& C) { const int st = b / 1024, sb = b % 1024, swz = sb ^ (((sb >> 9) & 1) << 5); R = (st >> 1) * 16 + swz / 64; C = (st & 1) * 32 + (swz % 64) / 2; }
__host__ __device__ __forceinline__ int perm32(int rho) { const int n = rho >> 4, i = rho & 15; return 8 * (i >> 2) + 4 * n + (i & 3); }
struct Unit { int pm, pn, kt0, nt; };
struct Gemm { const bf16_t* A; const bf16_t* Bt; int M, N, K; };
struct StaticOrder {
    int nM, nN, nwg, G, c, tailN, tailNt;
    __host__ __device__ void init(int M, int N, int G_, int c_) { nM = M / BM; nN = N / BM; nwg = nM * nN; G = G_; c = c_; tailN = 0; tailNt = 0; }
    __host__ __device__ bool next(int i, Unit& u) const {
        const int L = i * G + c;
        if (L >= nwg + tailN) return false;
        const bool tail = (L >= nwg); const int j = L - nwg;
        int wgid = tail ? 0 : L; { const int q = nwg / NXCD, r = nwg % NXCD, xcd = wgid % NXCD, off = wgid / NXCD; wgid = (xcd < r ? xcd * (q + 1) : r * (q + 1) + (xcd - r) * q) + off; }
        const int nig = WGM * nN, gid = wgid / nig, fm = gid * WGM, gsz = (nM - fm) < WGM ? (nM - fm) : WGM;
        const int pm_m = fm + ((wgid % nig) % gsz), pn_m = (wgid % nig) / gsz;
        u.pm = tail ? (j >> 1) : pm_m; u.pn = tail ? nN : pn_m; u.kt0 = tail ? (j & 1) * tailNt : 0; u.nt = tail ? tailNt : 0;
        return true;
    }
};

template <class Epi>
__device__ __forceinline__ void gemm_phase(LAS unsigned char* lds, const Gemm g, const StaticOrder& S, const Epi& E) {
    const int tid = threadIdx.x, wid = __builtin_amdgcn_readfirstlane(tid >> 6), lane = tid & 63, wr = wid >> 2, wc = wid & 3, fr = lane & 15, fq = lane >> 4;
    const int K = g.K, nt = K / BK;
    unsigned voffA[2], voffB[2];
#pragma unroll
    for (int i = 0; i < 2; ++i) { int R, C; stage_rc(tid * 16 + i * 8192, R, C); const int Rb = Epi::PERM ? ((R & ~31) + perm32(R & 31)) : R;
        voffA[i] = (unsigned)(R * K + C) * 2u; voffB[i] = (unsigned)(Rb * K + C) * 2u; }
    const size_t kstep = (size_t)(BK * 2);
    const size_t hstep = (size_t)HALF * K * 2;
    const size_t tstep = 2 * hstep;
    const unsigned ldsw = (unsigned)wid * 1024u;
    const int aoff = lds_byte(wr * 64 + fr, fq * 8), boff = lds_byte(wc * 32 + fr, fq * 8);
#define PG8_SA(b, h) (((b) * 2 + (h)) * HTB)
#define PG8_SB(b, h) ((4 + (b) * 2 + (h)) * HTB)
#define PG8_STAGE(bufoff, gbase, voff) do { _Pragma("unroll") for (int _i = 0; _i < 2; ++_i) \
        __builtin_amdgcn_global_load_lds((const unsigned*)((const char*)(gbase) + (voff)[_i]), (LAS unsigned*)(lds + (bufoff) + ldsw + _i * 8192), 16, 0, 0); } while (0)
#define PG8_LDA(dst, b, h) do { _Pragma("unroll") for (int m = 0; m < 4; ++m) _Pragma("unroll") for (int k = 0; k < 2; ++k) dst[m][k] = *(const LAS bf16x8*)(lds + PG8_SA(b, h) + aoff + m * 2048 + k * 1024); } while (0)
#define PG8_LDB(dst, b, h) do { _Pragma("unroll") for (int n = 0; n < 2; ++n) _Pragma("unroll") for (int k = 0; k < 2; ++k) dst[n][k] = *(const LAS bf16x8*)(lds + PG8_SB(b, h) + boff + n * 2048 + k * 1024); } while (0)
#define PG8_MMA(ai, bj, At, Bt) do { __builtin_amdgcn_s_setprio(1); _Pragma("unroll") for (int m = 0; m < 4; ++m) _Pragma("unroll") for (int n = 0; n < 2; ++n) _Pragma("unroll") for (int k = 0; k < 2; ++k) \
        acc[ai][bj][m][n] = __builtin_amdgcn_mfma_f32_16x16x32_bf16(Bt[n][k], At[m][k], acc[ai][bj][m][n], 0, 0, 0); __builtin_amdgcn_s_setprio(0); } while (0)
#define PG8_WAIT_V(n) asm volatile("s_waitcnt vmcnt(" #n ")" ::: "memory")
#define PG8_WAIT_L(n) asm volatile("s_waitcnt lgkmcnt(" #n ")" ::: "memory")
#define PG8_BAR __builtin_amdgcn_s_barrier()
#define PG8_SCHED __builtin_amdgcn_sched_barrier(0)
    Unit cur, nxt; int ui = 0;
    if (!S.next(0, cur)) return;
    f32x4 acc[2][2][4][2];
#pragma unroll
    for (int a = 0; a < 2; ++a)
#pragma unroll
        for (int b = 0; b < 2; ++b)
#pragma unroll
            for (int m = 0; m < 4; ++m)
#pragma unroll
                for (int n = 0; n < 2; ++n) acc[a][b][m][n] = (f32x4){0.f, 0.f, 0.f, 0.f};
    bf16x8 At[4][2], B0[2][2], B1[2][2];
    const char* cA = (const char*)g.A + (size_t)cur.pm * tstep + (size_t)cur.kt0 * kstep; const char* cB = (const char*)g.Bt + (size_t)cur.pn * tstep + (size_t)cur.kt0 * kstep;
    int unt = cur.nt ? cur.nt : nt;
    PG8_STAGE(PG8_SB(0, 0), cB, voffB); PG8_STAGE(PG8_SA(0, 0), cA, voffA); PG8_STAGE(PG8_SB(0, 1), cB + hstep, voffB); PG8_STAGE(PG8_SA(0, 1), cA + hstep, voffA);
    if (wr == 1) PG8_BAR;
    PG8_WAIT_V(4); PG8_BAR;
    PG8_STAGE(PG8_SB(1, 0), cB + kstep, voffB); PG8_STAGE(PG8_SA(1, 0), cA + kstep, voffA); PG8_STAGE(PG8_SB(1, 1), cB + hstep + kstep, voffB);
    PG8_WAIT_V(6); PG8_BAR;
    for (;;) {
        const bool has_next = S.next(ui + 1, nxt);
        const char* nA = has_next ? (const char*)g.A + (size_t)nxt.pm * tstep + (size_t)nxt.kt0 * kstep : cA; const char* nB = has_next ? (const char*)g.Bt + (size_t)nxt.pn * tstep + (size_t)nxt.kt0 * kstep : cB;
        for (int t = 0; t < unt; t += 2) {
            const bool last = (t == unt - 2);
            const char* a1 = cA + (size_t)(t + 1) * kstep;
            const char* a2 = last ? nA : cA + (size_t)(t + 2) * kstep; const char* b2 = last ? nB : cB + (size_t)(t + 2) * kstep;
            const char* a3 = a2 + kstep; const char* b3 = b2 + kstep;
            PG8_LDB(B0, 0, 0); PG8_SCHED; PG8_LDA(At, 0, 0); PG8_STAGE(PG8_SA(1, 1), a1 + hstep, voffA);
            PG8_WAIT_L(8); PG8_BAR; PG8_WAIT_L(0); PG8_MMA(0, 0, At, B0); PG8_BAR; PG8_SCHED;
            PG8_LDB(B1, 0, 1); PG8_STAGE(PG8_SB(0, 0), b2, voffB);
            PG8_BAR; PG8_WAIT_L(0); PG8_MMA(0, 1, At, B1); PG8_BAR;
            PG8_LDA(At, 0, 1); PG8_STAGE(PG8_SA(0, 0), a2, voffA);
            PG8_BAR; PG8_WAIT_L(0); PG8_MMA(1, 0, At, B0); PG8_BAR; PG8_SCHED;
            PG8_STAGE(PG8_SB(0, 1), b2 + hstep, voffB);
            PG8_WAIT_V(6); PG8_BAR; PG8_MMA(1, 1, At, B1); PG8_BAR;
            PG8_LDB(B0, 1, 0); PG8_SCHED; PG8_LDA(At, 1, 0); PG8_STAGE(PG8_SA(0, 1), a2 + hstep, voffA);
            PG8_WAIT_L(8); PG8_BAR; PG8_WAIT_L(0); PG8_MMA(0, 0, At, B0); PG8_BAR; PG8_SCHED;
            PG8_LDB(B1, 1, 1); PG8_STAGE(PG8_SB(1, 0), b3, voffB);
            PG8_BAR; PG8_WAIT_L(0); PG8_MMA(0, 1, At, B1); PG8_BAR;
            PG8_LDA(At, 1, 1); PG8_STAGE(PG8_SA(1, 0), a3, voffA);
            PG8_BAR; PG8_WAIT_L(0); PG8_MMA(1, 0, At, B0); PG8_BAR; PG8_SCHED;
            PG8_STAGE(PG8_SB(1, 1), b3 + hstep, voffB);
            PG8_WAIT_V(6); PG8_BAR; PG8_MMA(1, 1, At, B1); PG8_BAR;
        }
        E(acc, cur, wr, wc, fr, fq);
        if (!has_next) break;
#pragma unroll
        for (int a = 0; a < 2; ++a)
#pragma unroll
            for (int b = 0; b < 2; ++b)
#pragma unroll
                for (int m = 0; m < 4; ++m)
#pragma unroll
                    for (int n = 0; n < 2; ++n) acc[a][b][m][n] = (f32x4){0.f, 0.f, 0.f, 0.f};
        cur = nxt; cA = nA; cB = nB; unt = cur.nt ? cur.nt : nt; ++ui;
    }
    PG8_WAIT_V(0);
    if (wr == 0) PG8_BAR;
    PG8_BAR;
#undef PG8_SA
#undef PG8_SB
#undef PG8_STAGE
#undef PG8_LDA
#undef PG8_LDB
#undef PG8_MMA
#undef PG8_WAIT_V
#undef PG8_WAIT_L
#undef PG8_BAR
#undef PG8_SCHED
}
}

typedef f32x4 AccT[2][2][4][2];
struct EpiZ {
    static constexpr bool PERM = true;
    unsigned char* ws;
    __device__ __forceinline__ void operator()(const AccT& acc, const pg8::Unit& u, int wr, int wc, int fr, int fq) const {
        const int pn = u.pn; size_t base; int ld, c0;
        if (pn < 16) { base = WS_ZR + (size_t)(pn >> 2) * (64 * MiB); ld = 1024; c0 = (pn & 3) * 256; }
        else if (pn < 18) { base = WS_ZU; ld = 512; c0 = (pn - 16) * 256; }
        else if (pn < 20) { base = WS_ZGB; ld = 512; c0 = (pn - 18) * 256; }
        else if (pn < 24) { base = WS_ZMA; ld = 1024; c0 = (pn - 20) * 256; }
        else if (pn < 28) { base = WS_ZMB; ld = 1024; c0 = (pn - 24) * 256; }
        else { base = u.kt0 ? WS_ZX2 : WS_ZX; ld = 256; c0 = 0; }
        bf16_t* O = (bf16_t*)(ws + base);
        const int row0 = u.pm * 256 + wr * 64 + fr, col0 = c0 + wc * 32 + 8 * fq;
#pragma unroll
        for (int ai = 0; ai < 2; ++ai)
#pragma unroll
            for (int m = 0; m < 4; ++m) { bf16_t* rowp = O + (size_t)(row0 + ai * 128 + m * 16) * ld + col0;
#pragma unroll
                for (int bj = 0; bj < 2; ++bj) { const f32x4 v0 = acc[ai][bj][m][0], v1 = acc[ai][bj][m][1];
                    u32x4 w; w.x = pk2bf(v0[0], v0[1]); w.y = pk2bf(v0[2], v0[3]); w.z = pk2bf(v1[0], v1[1]); w.w = pk2bf(v1[2], v1[3]);
                    *(u32x4*)(rowp + bj * 128) = w; } }
    }
};
struct EpiGlu {
    static constexpr bool PERM = true;
    unsigned char* ws; const float* bglu; bf16_t* yb;
    __device__ __forceinline__ void operator()(const AccT& acc, const pg8::Unit& u, int wr, int wc, int fr, int fq) const {
        const int j0 = u.pn * 128 + wc * 32 + 8 * fq; const int row0 = u.pm * 256 + wr * 64 + fr;
        const bf16_t* zgb = (const bf16_t*)(ws + WS_ZGB);
        u32x4 gvv[2][4];
#pragma unroll
        for (int ai = 0; ai < 2; ++ai)
#pragma unroll
            for (int m = 0; m < 4; ++m) gvv[ai][m] = *(const u32x4*)(zgb + (size_t)(row0 + ai * 128 + m * 16) * 512 + j0);
        const f32x4 b1a = *(const f32x4*)(bglu + j0), b1b = *(const f32x4*)(bglu + j0 + 4), b2a = *(const f32x4*)(bglu + 512 + j0), b2b = *(const f32x4*)(bglu + 512 + j0 + 4);
#pragma unroll
        for (int ai = 0; ai < 2; ++ai)
#pragma unroll
            for (int m = 0; m < 4; ++m) { const size_t row = (size_t)(row0 + ai * 128 + m * 16);
                float gt[8]; UNPACK8(gvv[ai][m], gt);
                float o[8];
#pragma unroll
                for (int e = 0; e < 8; ++e) { const float g1 = acc[ai][0][m][e >> 2][e & 3] + ((e < 4) ? b1a[e & 3] : b1b[e & 3]);
                    const float g2 = acc[ai][1][m][e >> 2][e & 3] + ((e < 4) ? b2a[e & 3] : b2b[e & 3]);
                    o[e] = g1 * fsigmoid(g2) * gt[e] * fsigmoid(gt[e]); }
                u32x4 w; w.x = pk2bf(o[0], o[1]); w.y = pk2bf(o[2], o[3]); w.z = pk2bf(o[4], o[5]); w.w = pk2bf(o[6], o[7]);
                *(u32x4*)(yb + row * 512 + j0) = w; }
    }
};
template <int MODE> struct EpiGate {
    static constexpr bool PERM = true;
    const bf16_t* gate; const bf16_t* addend; bf16_t* O;
    __device__ __forceinline__ void operator()(const AccT& acc, const pg8::Unit& u, int wr, int wc, int fr, int fq) const {
        const int row0 = u.pm * 256 + wr * 64 + fr, col0 = u.pn * 256 + wc * 32 + 8 * fq;
#pragma unroll
        for (int ai = 0; ai < 2; ++ai) {
            u32x4 gvv[4][2], avv[4][2];
#pragma unroll
            for (int m = 0; m < 4; ++m)
#pragma unroll
                for (int bj = 0; bj < 2; ++bj) { const size_t ro = (size_t)(row0 + ai * 128 + m * 16) * 1024 + col0 + bj * 128;
                    gvv[m][bj] = *(const u32x4*)(gate + ro); if (MODE == 1) avv[m][bj] = *(const u32x4*)(addend + ro); }
#pragma unroll
            for (int m = 0; m < 4; ++m)
#pragma unroll
                for (int bj = 0; bj < 2; ++bj) { const size_t ro = (size_t)(row0 + ai * 128 + m * 16) * 1024 + col0 + bj * 128;
                    float gt[8], ad[8]; UNPACK8(gvv[m][bj], gt);
                    if (MODE == 1) UNPACK8(avv[m][bj], ad);
                    float o[8];
#pragma unroll
                    for (int e = 0; e < 8; ++e) { o[e] = acc[ai][bj][m][e >> 2][e & 3] * fsigmoid(gt[e]); if (MODE == 1) o[e] += ad[e]; }
                    u32x4 w; w.x = pk2bf(o[0], o[1]); w.y = pk2bf(o[2], o[3]); w.z = pk2bf(o[4], o[5]); w.w = pk2bf(o[6], o[7]);
                    *(u32x4*)(O + ro) = w; }
        }
    }
};
struct EpiOut {
    static constexpr bool PERM = true;
    bf16_t* O;
    __device__ __forceinline__ void operator()(const AccT& acc, const pg8::Unit& u, int wr, int wc, int fr, int fq) const {
        const int row0 = u.pm * 256 + wr * 64 + fr, col0 = u.pn * 256 + wc * 32 + 8 * fq;
#pragma unroll
        for (int ai = 0; ai < 2; ++ai)
#pragma unroll
            for (int m = 0; m < 4; ++m) { bf16_t* rowp = O + (size_t)(row0 + ai * 128 + m * 16) * 1024 + col0;
#pragma unroll
                for (int bj = 0; bj < 2; ++bj) { const f32x4 v0 = acc[ai][bj][m][0], v1 = acc[ai][bj][m][1];
                    u32x4 w; w.x = pk2bf(v0[0], v0[1]); w.y = pk2bf(v0[2], v0[3]); w.z = pk2bf(v1[0], v1[1]); w.w = pk2bf(v1[2], v1[3]);
                    *(u32x4*)(rowp + bj * 128) = w; } }
    }
};

__device__ __forceinline__ void sincos_d(double x, double& s, double& c) {
    const double n = rint(x * 0.15915494309189533577);
    double r = fma(-n, 6.283185307179586476925, x); r = fma(-n, 2.4492935982947064e-16, r);
    const double r2 = r * r;
    double t = -1.0 / 1.0888869450418352e28;
    t = fma(t, r2, 1.0 / 1.5511210043330986e25);
    t = fma(t, r2, -1.0 / 2.5852016738884978e22);
    t = fma(t, r2, 1.0 / 5.109094217170944e19);
    t = fma(t, r2, -1.0 / 1.21645100408832e17);
    t = fma(t, r2, 1.0 / 355687428096000.0);
    t = fma(t, r2, -1.0 / 1307674368000.0);
    t = fma(t, r2, 1.0 / 6227020800.0);
    t = fma(t, r2, -1.0 / 39916800.0);
    t = fma(t, r2, 1.0 / 362880.0);
    t = fma(t, r2, -1.0 / 5040.0);
    t = fma(t, r2, 1.0 / 120.0);
    t = fma(t, r2, -1.0 / 6.0);
    t = fma(t, r2, 1.0);
    s = r * t;
    double q = 1.0 / 3.0488834461171384e29;
    q = fma(q, r2, -1.0 / 4.0329146112660565e26);
    q = fma(q, r2, 1.0 / 6.204484017332394e23);
    q = fma(q, r2, -1.0 / 1.1240007277776077e21);
    q = fma(q, r2, 1.0 / 2.43290200817664e18);
    q = fma(q, r2, -1.0 / 6402373705728000.0);
    q = fma(q, r2, 1.0 / 20922789888000.0);
    q = fma(q, r2, -1.0 / 87178291200.0);
    q = fma(q, r2, 1.0 / 479001600.0);
    q = fma(q, r2, -1.0 / 3628800.0);
    q = fma(q, r2, 1.0 / 40320.0);
    q = fma(q, r2, -1.0 / 720.0);
    q = fma(q, r2, 1.0 / 24.0);
    q = fma(q, r2, -0.5);
    q = fma(q, r2, 1.0);
    c = q;
}

__device__ __forceinline__ void transpose_tile(const float* W, int ldw, int scol0, int k0, bf16_t* Wt, int ldt, int drow0, bool zero, float* tile, int tid) {
#pragma unroll
    for (int i = 0; i < 2; ++i) { const int kk = (tid >> 4) + i * 32, nn = (tid & 15) * 4;
        f32x4 v = (f32x4){0.f, 0.f, 0.f, 0.f};
        if (!zero) v = *(const f32x4*)(W + (size_t)(k0 + kk) * ldw + scol0 + nn);
        tile[kk * 65 + nn + 0] = v[0]; tile[kk * 65 + nn + 1] = v[1]; tile[kk * 65 + nn + 2] = v[2]; tile[kk * 65 + nn + 3] = v[3]; }
    __syncthreads();
    { const int n = tid >> 3, kq = (tid & 7) * 8;
      u32x4 o; o.x = pk2bf(tile[(kq + 0) * 65 + n], tile[(kq + 1) * 65 + n]); o.y = pk2bf(tile[(kq + 2) * 65 + n], tile[(kq + 3) * 65 + n]);
      o.z = pk2bf(tile[(kq + 4) * 65 + n], tile[(kq + 5) * 65 + n]); o.w = pk2bf(tile[(kq + 6) * 65 + n], tile[(kq + 7) * 65 + n]);
      *(u32x4*)(Wt + (size_t)(drow0 + n) * ldt + k0 + kq) = o; }
    __syncthreads();
}

__device__ void phase_prologue(const Params& p, unsigned char* ldsg) {
    float* tile = (float*)ldsg;
    const int tid = threadIdx.x, bid = blockIdx.x, G = gridDim.x, lane = tid & 63, wave = tid >> 6;
    unsigned char* ws = p.ws;
    for (int job = bid; job < 2656; job += G) {
        const float* W; int ldw, scol0, k0, ldt, drow0; bf16_t* Wt; bool zero = false; int j = job;
        if (j < 1856) { const int nt = j >> 4, kt = j & 15, n = nt * 64; W = p.in[2]; ldw = INW; k0 = kt * 64; Wt = (bf16_t*)(ws + WS_WIN); ldt = 1024; drow0 = n;
            if (n < 3072) scol0 = n; else if (n < 7168) scol0 = n + 128; else if (n < 7296) scol0 = n - 4096; else { scol0 = 0; zero = true; } }
        else if ((j -= 1856) < 128) { const int nt = j >> 3, kt = j & 7; W = p.in[21]; ldw = 1024; k0 = kt * 64; Wt = (bf16_t*)(ws + WS_WGLU); ldt = 512; drow0 = nt * 64;
            scol0 = ((nt & 3) >> 1) * 512 + (nt >> 2) * 128 + (nt & 1) * 64; }
        else if ((j -= 128) < 256) { const int nt = j >> 4, kt = j & 15; W = p.in[23]; ldw = 1024; k0 = kt * 64; Wt = (bf16_t*)(ws + WS_WPA); ldt = 1024; drow0 = nt * 64; scol0 = nt * 64; }
        else if ((j -= 256) < 128) { const int nt = j >> 3, kt = j & 7; W = p.in[24]; ldw = 1024; k0 = kt * 64; Wt = (bf16_t*)(ws + WS_WPB); ldt = 512; drow0 = nt * 64; scol0 = nt * 64; }
        else if ((j -= 128) < 256) { const int nt = j >> 4, kt = j & 15; W = p.in[25]; ldw = 1024; k0 = kt * 64; Wt = (bf16_t*)(ws + WS_WOUT); ldt = 1024; drow0 = nt * 64; scol0 = nt * 64; }
        else { j -= 256; const int nt = j & 15; W = (j < 16) ? p.in[5] : p.in[7]; ldw = 1024; k0 = 0; Wt = (bf16_t*)(ws + ((j < 16) ? WS_WUP : WS_AUP)); ldt = 64; drow0 = nt * 64; scol0 = nt * 64; }
        transpose_tile(W, ldw, scol0, k0, Wt, ldt, drow0, zero, tile, tid);
    }
    {
        const float* x = p.in[0]; const float* gn = p.in[1]; bf16_t* hb = (bf16_t*)p.out;
        f32x4 gv[4];
#pragma unroll
        for (int i = 0; i < 4; ++i) gv[i] = *(const f32x4*)(gn + i * 256 + lane * 4);
        for (int row = bid * 8 + wave; row < NTOK; row += G * 8) {
            f32x4 v[4]; float ss = 0.f;
#pragma unroll
            for (int i = 0; i < 4; ++i) { v[i] = *(const f32x4*)(x + (size_t)row * 1024 + i * 256 + lane * 4); ss += v[i][0] * v[i][0] + v[i][1] * v[i][1] + v[i][2] * v[i][2] + v[i][3] * v[i][3]; }
            ss = allred64(ss);
            const float rs = rsqrtf(ss * (1.0f / 1024.0f) + 1e-6f);
#pragma unroll
            for (int i = 0; i < 4; ++i) { u32x2 o; o.x = pk2bf(v[i][0] * rs * gv[i][0], v[i][1] * rs * gv[i][1]); o.y = pk2bf(v[i][2] * rs * gv[i][2], v[i][3] * rs * gv[i][3]);
                *(u32x2*)(hb + (size_t)row * 1024 + i * 256 + lane * 4) = o; }
        }
    }
    {
        const int idx = bid * 512 + tid;
        if (idx < 2048) {
            const int g = idx >> 6, pp = idx & 63;
            const double dt = exp((double)p.in[15][g]); const double lr = (double)p.in[13][idx], li = (double)p.in[14][idx];
            const double mag = exp(lr * dt); double sn, cs; sincos_d(li * dt, sn, cs);
            const double abr = mag * cs, abi = mag * sn;
            const double den = lr * lr + li * li, nr = abr - 1.0;
            const double fre = (nr * lr + abi * li) / den, fim = (abi * lr - nr * li) / den;
            ((f32x2*)(ws + WS_S5C + S5_AB))[idx] = (f32x2){(float)abr, (float)abi};
            const double mag2 = exp(lr * dt * 256.0); double sn2, cs2; sincos_d(li * dt * 256.0, sn2, cs2);
            ((f32x2*)(ws + WS_S5C + S5_APOW))[idx] = (f32x2){(float)(mag2 * cs2), (float)(mag2 * sn2)};
            bf16_t* bbt = (bf16_t*)(ws + WS_S5C + S5_BBRE);
            for (int h = 0; h < 16; ++h) { const double br = (double)p.in[16][idx * 16 + h], bi = (double)p.in[17][idx * 16 + h];
                bbt[(size_t)(g * 128 + pp) * 16 + h] = f2bf((float)(fre * br - fim * bi)); bbt[(size_t)(g * 128 + 64 + pp) * 16 + h] = f2bf((float)(fre * bi + fim * br)); }
            bf16_t* cmt = (bf16_t*)(ws + WS_S5C + S5_CMT);
            for (int h = 0; h < 16; ++h) { cmt[(g * 16 + h) * 128 + 2 * pp] = f2bf(p.in[18][(g * 16 + h) * 64 + pp]); cmt[(g * 16 + h) * 128 + 2 * pp + 1] = f2bf(-p.in[19][(g * 16 + h) * 64 + pp]); }
        }
    }
}

__device__ __forceinline__ void shift8(const u32x4& cv, const u32x4& pv, const f32x4& m0, const f32x4& m1, bool first, float* o) {
    float c[8], pr[8]; UNPACK8(cv, c); UNPACK8(pv, pr);
#pragma unroll
    for (int e = 0; e < 8; ++e) { const float pe = first ? 0.f : pr[e]; const float m = (e < 4) ? m0[e & 3] : m1[e & 3]; o[e] = c[e] + m * (pe - c[e]); }
}
struct PrRaw { u32x4 rc[2], rp[2], kc[2], kp[2]; };
__device__ __forceinline__ void pr_load(PrRaw& q, const bf16_t* zr, const bf16_t* zk, size_t g, size_t gp, int h, int fq) {
#pragma unroll
    for (int ks = 0; ks < 2; ++ks) { const int cb = ks * 32 + fq * 8;
        q.rc[ks] = *(const u32x4*)(zr + g * 1024 + h * 64 + cb); q.rp[ks] = *(const u32x4*)(zr + gp * 1024 + h * 64 + cb);
        q.kc[ks] = *(const u32x4*)(zk + g * 1024 + h * 64 + cb); q.kp[ks] = *(const u32x4*)(zk + gp * 1024 + h * 64 + cb); }
}
__device__ __forceinline__ void shift8s(const u32x4& c1, const u32x4& c2, const u32x4& p1, const u32x4& p2, const f32x4& m0, const f32x4& m1, bool first, float* o) {
    float a[8], b[8], c[8], d[8]; UNPACK8(c1, a); UNPACK8(c2, b); UNPACK8(p1, c); UNPACK8(p2, d);
#pragma unroll
    for (int e = 0; e < 8; ++e) { const float cc = a[e] + b[e], pe = first ? 0.f : c[e] + d[e]; const float m = (e < 4) ? m0[e & 3] : m1[e & 3]; o[e] = cc + m * (pe - cc); }
}
constexpr int PR_KS = 0, PR_RS = 4352, PR_IC = 8704, PR_EE = 11008, PR_WAVE = 13312;
__device__ void phase_prep(const Params& p, unsigned char* ldsg) {
    const int tid = threadIdx.x, lane = tid & 63, wave = __builtin_amdgcn_readfirstlane(tid >> 6), fr = lane & 15, fq = lane >> 4;
    LAS unsigned char* sc = (LAS unsigned char*)ldsg + wave * PR_WAVE;
    unsigned char* ws = p.ws;
    const bf16_t* zr = (const bf16_t*)(ws + WS_ZR); const bf16_t* zk = (const bf16_t*)(ws + WS_ZK); const bf16_t* zx = (const bf16_t*)(ws + WS_ZX); const bf16_t* zx2 = (const bf16_t*)(ws + WS_ZX2);
    const bf16_t* wupT = (const bf16_t*)(ws + WS_WUP); const bf16_t* aupT = (const bf16_t*)(ws + WS_AUP);
    bf16_t* ICg = (bf16_t*)(ws + WS_IC); bf16_t* EEg = (bf16_t*)(ws + WS_EE); float* INV = (float*)(ws + WS_INVN); float* RK = (float*)(ws + WS_RK);
    const float* mu = p.in[3];
    const int nw = gridDim.x * 8;
    for (int tb = blockIdx.x * 8 + wave; tb < NTOK / 16; tb += nw) {
        const size_t g0 = (size_t)tb * 16, g = g0 + fr; const bool first = ((g & (size_t)(SEQ - 1)) == 0); const size_t gp = first ? g : g - 1;
        bf16x8 Aw[2], Aa[2];
#pragma unroll
        for (int ks = 0; ks < 2; ++ks) {
            const int cb = ks * 32 + fq * 8; float o[8];
            { const u32x4 cv = *(const u32x4*)(zx + g * 256 + cb), pv = *(const u32x4*)(zx + gp * 256 + cb), cv2 = *(const u32x4*)(zx2 + g * 256 + cb), pv2 = *(const u32x4*)(zx2 + gp * 256 + cb);
              shift8s(cv, cv2, pv, pv2, *(const f32x4*)(mu + 3072 + cb), *(const f32x4*)(mu + 3072 + cb + 4), first, o);
              u32x4 w; w.x = pk2bf(ftanh(o[0]), ftanh(o[1])); w.y = pk2bf(ftanh(o[2]), ftanh(o[3])); w.z = pk2bf(ftanh(o[4]), ftanh(o[5])); w.w = pk2bf(ftanh(o[6]), ftanh(o[7])); Aw[ks] = __builtin_bit_cast(bf16x8, w); }
            { const u32x4 cv = *(const u32x4*)(zx + g * 256 + 64 + cb), pv = *(const u32x4*)(zx + gp * 256 + 64 + cb), cv2 = *(const u32x4*)(zx2 + g * 256 + 64 + cb), pv2 = *(const u32x4*)(zx2 + gp * 256 + 64 + cb);
              shift8s(cv, cv2, pv, pv2, *(const f32x4*)(mu + 3136 + cb), *(const f32x4*)(mu + 3136 + cb + 4), first, o);
              u32x4 w; w.x = pk2bf(o[0], o[1]); w.y = pk2bf(o[2], o[3]); w.z = pk2bf(o[4], o[5]); w.w = pk2bf(o[6], o[7]); Aa[ks] = __builtin_bit_cast(bf16x8, w); }
        }
        PrRaw q; pr_load(q, zr, zk, g, gp, 0, fq);
      for (int h = 0; h < 16; ++h) {
        const PrRaw c = q;
        if (h + 1 < 16) pr_load(q, zr, zk, g, gp, h + 1, fq);
#pragma unroll
        for (int ks = 0; ks < 2; ++ks) {
            const int cb = ks * 32 + fq * 8; float o[8];
            { shift8(c.rc[ks], c.rp[ks], *(const f32x4*)(mu + h * 64 + cb), *(const f32x4*)(mu + h * 64 + cb + 4), first, o);
              *(LAS f32x4*)(sc + PR_RS + fr * 272 + cb * 4) = (f32x4){o[0], o[1], o[2], o[3]}; *(LAS f32x4*)(sc + PR_RS + fr * 272 + cb * 4 + 16) = (f32x4){o[4], o[5], o[6], o[7]}; }
            { shift8(c.kc[ks], c.kp[ks], *(const f32x4*)(mu + 1024 + h * 64 + cb), *(const f32x4*)(mu + 1024 + h * 64 + cb + 4), first, o);
              *(LAS f32x4*)(sc + PR_KS + fr * 272 + cb * 4) = (f32x4){o[0], o[1], o[2], o[3]}; *(LAS f32x4*)(sc + PR_KS + fr * 272 + cb * 4 + 16) = (f32x4){o[4], o[5], o[6], o[7]}; }
        }
        wave_lds_sync();
        float ss[4] = {0.f, 0.f, 0.f, 0.f}, rk[4] = {0.f, 0.f, 0.f, 0.f};
#pragma unroll
        for (int nt = 0; nt < 4; ++nt) {
            f32x4 lw = (f32x4){0.f, 0.f, 0.f, 0.f}, la = (f32x4){0.f, 0.f, 0.f, 0.f};
#pragma unroll
            for (int ks = 0; ks < 2; ++ks) {
                const bf16x8 bw = *(const bf16x8*)(wupT + (size_t)(h * 64 + nt * 16 + fr) * 64 + ks * 32 + fq * 8);
                const bf16x8 ba = *(const bf16x8*)(aupT + (size_t)(h * 64 + nt * 16 + fr) * 64 + ks * 32 + fq * 8);
                lw = __builtin_amdgcn_mfma_f32_16x16x32_bf16(Aw[ks], bw, lw, 0, 0, 0);
                la = __builtin_amdgcn_mfma_f32_16x16x32_bf16(Aa[ks], ba, la, 0, 0, 0);
            }
            const int c = nt * 16 + fr, cc = h * 64 + c;
            const float w0c = p.in[4][cc], a0c = p.in[6][cc], kkc = p.in[8][cc], kac = p.in[9][cc], rkc = p.in[10][cc];
#pragma unroll
            for (int j = 0; j < 4; ++j) {
                const int tok = fq * 4 + j;
                const float kraw = *(const LAS float*)(sc + PR_KS + tok * 272 + c * 4), rr = *(const LAS float*)(sc + PR_RS + tok * 272 + c * 4);
                const float ee = 0.6065306597126334f * fsigmoid(w0c + lw[j]);
                const float ic = fsigmoid(a0c + la[j]);
                const float kk = kraw * kkc, kh = kraw * (1.0f + (ic - 1.0f) * kac);
                ss[j] += kk * kk; rk[j] += rr * kh * rkc;
                *(LAS bf16_t*)(sc + PR_IC + tok * 144 + c * 2) = f2bf(ic); *(LAS bf16_t*)(sc + PR_EE + tok * 144 + c * 2) = f2bf(ee);
            }
        }
#pragma unroll
        for (int j = 0; j < 4; ++j) { ss[j] = allred16(ss[j]); rk[j] = allred16(rk[j]); }
        if (fr == 0) {
#pragma unroll
            for (int j = 0; j < 4; ++j) { const size_t gi = (g0 + fq * 4 + j) * 16 + h; INV[gi] = 1.0f / fmaxf(sqrtf(ss[j]), 1e-12f); RK[gi] = rk[j]; }
        }
        wave_lds_sync();
#pragma unroll
        for (int i = 0; i < 2; ++i) { const int piece = lane + i * 64, row = piece >> 3, c8 = (piece & 7) * 8;
            *(u32x4*)(ICg + (g0 + row) * 1024 + h * 64 + c8) = *(const LAS u32x4*)(sc + PR_IC + row * 144 + c8 * 2);
            *(u32x4*)(EEg + (g0 + row) * 1024 + h * 64 + c8) = *(const LAS u32x4*)(sc + PR_EE + row * 144 + c8 * 2); }
        wave_lds_sync();
      }
    }
}

constexpr int WK_OW = 0, WK_OK = 8192, WK_OA = 16384, WK_OB = 24576, WK_OR = 32768, WK_OV = 40960, WK_BUF = 44032;
constexpr int WK_MU = 2 * WK_BUF, WK_PAR = WK_MU + 1088;
struct LdRaw { u32x4 rc, rp, kc, kp, ic, ee, vc, vp; float inv; };
__device__ __forceinline__ void ld_load(LdRaw& q, const unsigned char* ws, int b, int h, int rq, int t, int cg, int vsel) {
    const bf16_t* zr = (const bf16_t*)(ws + WS_ZR); const bf16_t* zk = (const bf16_t*)(ws + WS_ZK); const bf16_t* zv = (const bf16_t*)(ws + WS_ZV);
    const bf16_t* ICg = (const bf16_t*)(ws + WS_IC); const bf16_t* EEg = (const bf16_t*)(ws + WS_EE); const float* INV = (const float*)(ws + WS_INVN);
    const size_t g = (size_t)b * SEQ + t; const size_t gp = (t > 0) ? g - 1 : g;
    q.rc = *(const u32x4*)(zr + g * 1024 + h * 64 + cg); q.rp = *(const u32x4*)(zr + gp * 1024 + h * 64 + cg);
    q.kc = *(const u32x4*)(zk + g * 1024 + h * 64 + cg); q.kp = *(const u32x4*)(zk + gp * 1024 + h * 64 + cg);
    q.ic = *(const u32x4*)(ICg + g * 1024 + h * 64 + cg); q.ee = *(const u32x4*)(EEg + g * 1024 + h * 64 + cg);
    q.vc = *(const u32x4*)(zv + g * 1024 + h * 64 + rq * 16 + vsel * 8); q.vp = *(const u32x4*)(zv + gp * 1024 + h * 64 + rq * 16 + vsel * 8);
    q.inv = INV[g * 16 + h];
}
__device__ __forceinline__ void ld_process(const LdRaw& q, LAS unsigned char* buf, const LAS unsigned char* lds, int tt, int cg, int c7, bool first) {
    const LAS float* MU = (const LAS float*)(lds + WK_MU); const LAS float* PAR = (const LAS float*)(lds + WK_PAR);
    float r[8], k[8], ic[8], ee[8];
    { const f32x4 m0 = *(const LAS f32x4*)(MU + cg), m1 = *(const LAS f32x4*)(MU + cg + 4); shift8(q.rc, q.rp, m0, m1, first, r); }
    { const f32x4 m0 = *(const LAS f32x4*)(MU + 64 + cg), m1 = *(const LAS f32x4*)(MU + 64 + cg + 4); shift8(q.kc, q.kp, m0, m1, first, k); }
    UNPACK8(q.ic, ic); UNPACK8(q.ee, ee);
    const f32x4 kk0 = *(const LAS f32x4*)(PAR + cg), kk1 = *(const LAS f32x4*)(PAR + cg + 4), ka0 = *(const LAS f32x4*)(PAR + 64 + cg), ka1 = *(const LAS f32x4*)(PAR + 64 + cg + 4);
    float w[8], kh[8], a[8], bq[8];
#pragma unroll
    for (int e = 0; e < 8; ++e) { const float kkc = (e < 4) ? kk0[e & 3] : kk1[e & 3], kac = (e < 4) ? ka0[e & 3] : ka1[e & 3];
        kh[e] = k[e] * (1.0f + (ic[e] - 1.0f) * kac); const float kn = k[e] * kkc * q.inv; a[e] = -kn; bq[e] = kn * ic[e];
        w[e] = __builtin_amdgcn_exp2f(ee[e] * -1.4426950408889634f); }
    LAS unsigned char* dst = buf + tt * 256 + c7 * 16;
    *(LAS f32x4*)(dst + WK_OW) = (f32x4){w[0], w[1], w[2], w[3]}; *(LAS f32x4*)(dst + WK_OW + 128) = (f32x4){w[4], w[5], w[6], w[7]};
    *(LAS f32x4*)(dst + WK_OK) = (f32x4){kh[0], kh[1], kh[2], kh[3]}; *(LAS f32x4*)(dst + WK_OK + 128) = (f32x4){kh[4], kh[5], kh[6], kh[7]};
    *(LAS f32x4*)(dst + WK_OA) = (f32x4){a[0], a[1], a[2], a[3]}; *(LAS f32x4*)(dst + WK_OA + 128) = (f32x4){a[4], a[5], a[6], a[7]};
    *(LAS f32x4*)(dst + WK_OB) = (f32x4){bq[0], bq[1], bq[2], bq[3]}; *(LAS f32x4*)(dst + WK_OB + 128) = (f32x4){bq[4], bq[5], bq[6], bq[7]};
    *(LAS f32x4*)(dst + WK_OR) = (f32x4){r[0], r[1], r[2], r[3]}; *(LAS f32x4*)(dst + WK_OR + 128) = (f32x4){r[4], r[5], r[6], r[7]};
    if (c7 < 2) { float v[8]; const f32x4 m0 = *(const LAS f32x4*)(MU + 256 + c7 * 8), m1 = *(const LAS f32x4*)(MU + 256 + c7 * 8 + 4); shift8(q.vc, q.vp, m0, m1, first, v);
#pragma unroll
        for (int e = 0; e < 8; ++e) *(LAS float*)(buf + WK_OV + (c7 * 8 + e) * 128 + tt * 4) = v[e]; }
}
struct WkOps { f32x4 w, k, a, b, r; };
__device__ __forceinline__ WkOps wk_ld(const LAS unsigned char* bb, int tt, int cl, int lrow) {
    WkOps o; const int cs = ((cl >> 1) + 8 * (cl & 1)) * 16;
    o.w = *(const LAS f32x4*)(bb + WK_OW + tt * 256 + cs); o.k = *(const LAS f32x4*)(bb + WK_OK + tt * 256 + cs);
    o.a = *(const LAS f32x4*)(bb + WK_OA + tt * 256 + cs); o.b = *(const LAS f32x4*)(bb + WK_OB + tt * 256 + cs);
    o.r = *(const LAS f32x4*)(bb + WK_OR + tt * 256 + cs);
    return o;
}
__device__ __forceinline__ float wk_step(f32x2& S01, f32x2& S23, const WkOps& o, const float vv) {
    const f32x2 pa = S01 * (f32x2){o.a[0], o.a[1]} + S23 * (f32x2){o.a[2], o.a[3]};
    const float sa = allred16(pa[0] + pa[1]);
    S01 = S01 * (f32x2){o.w[0], o.w[1]} + (f32x2){o.k[0], o.k[1]} * vv;
    S23 = S23 * (f32x2){o.w[2], o.w[3]} + (f32x2){o.k[2], o.k[3]} * vv;
    S01 = S01 + (f32x2){o.b[0], o.b[1]} * sa;
    S23 = S23 + (f32x2){o.b[2], o.b[3]} * sa;
    const f32x2 py = S01 * (f32x2){o.r[0], o.r[1]} + S23 * (f32x2){o.r[2], o.r[3]};
    return py[0] + py[1];
}

__device__ void phase_wkv(const Params& p, unsigned char* ldsg, int vb) {
    LAS unsigned char* lds = (LAS unsigned char*)ldsg;
    const int tid = threadIdx.x, lane = tid & 63, wave = __builtin_amdgcn_readfirstlane(tid >> 6);
    unsigned char* ws = p.ws;
    bf16_t* yraw = (bf16_t*)p.out;
    const float* mu = p.in[3];
    for (int it = vb; it < 256; it += gridDim.x) {
        const int xcd = it & 7, idx = it >> 3, bh = xcd * 8 + (idx >> 2), rq = idx & 3, b = bh >> 4, h = bh & 15;
        __syncthreads();
        if (tid < 272) { float m = 0.f;
            if (tid < 64) m = mu[h * 64 + tid]; else if (tid < 128) m = mu[1024 + h * 64 + tid - 64]; else if (tid >= 256) m = mu[2048 + h * 64 + rq * 16 + tid - 256];
            ((LAS float*)(lds + WK_MU))[tid] = m; }
        if (tid >= 320 && tid < 448) { const int i2 = tid - 320; ((LAS float*)(lds + WK_PAR))[i2] = (i2 < 64) ? p.in[8][h * 64 + i2] : p.in[9][h * 64 + i2 - 64]; }
        __syncthreads();
        const int L = (tid - 256) & 255, ltt = L >> 3, c7 = L & 7, cg = c7 * 8;
        LdRaw q;
        if (wave >= 4) {
            ld_load(q, ws, b, h, rq, ltt, cg, c7 & 1);
            ld_process(q, lds, lds, ltt, cg, c7, ltt == 0);
            ld_load(q, ws, b, h, rq, 32 + ltt, cg, c7 & 1);
        }
        __syncthreads();
        f32x2 S01 = (f32x2){0.f, 0.f}, S23 = (f32x2){0.f, 0.f};
        const int rg = lane >> 4, cl = lane & 15, lrow = (wave & 3) * 4 + rg;
        bf16_t* yout = yraw + ((size_t)b * SEQ + cl) * 1024 + h * 64 + rq * 16 + lrow;
        for (int tile = 0; tile < 256; ++tile) {
            if (wave < 4) {
                const LAS unsigned char* bb = lds + (tile & 1) * WK_BUF;
                WkOps o0 = wk_ld(bb, 0, cl, lrow), o1 = wk_ld(bb, 1, cl, lrow);
                f32x4 vcur = *(const LAS f32x4*)(bb + WK_OV + lrow * 128), vnx = vcur;
#pragma unroll
                for (int hlf = 0; hlf < 2; ++hlf) {
                    float yp[16];
#pragma unroll
                    for (int i = 0; i < 16; i += 2) {
                        const int tt = hlf * 16 + i;
                        if ((tt & 3) == 0 && tt + 4 < 32) vnx = *(const LAS f32x4*)(bb + WK_OV + lrow * 128 + (tt + 4) * 4);
                        const WkOps o2 = wk_ld(bb, (tt + 2 < 32) ? tt + 2 : 31, cl, lrow);
                        __builtin_amdgcn_sched_barrier(0x11);
                        yp[i] = wk_step(S01, S23, o0, vcur[tt & 3]);
                        const WkOps o3 = wk_ld(bb, (tt + 3 < 32) ? tt + 3 : 31, cl, lrow);
                        __builtin_amdgcn_sched_barrier(0x11);
                        yp[i + 1] = wk_step(S01, S23, o1, vcur[(tt + 1) & 3]);
                        if ((tt & 3) == 2) vcur = vnx;
                        o0 = o2; o1 = o3;
                    }
#pragma unroll
                    for (int i = 0; i < 8; ++i) { const float keep = (cl & 8) ? yp[i + 8] : yp[i], send = (cl & 8) ? yp[i] : yp[i + 8]; yp[i] = keep + dppf<0x128>(send); }
#pragma unroll
                    for (int i = 0; i < 4; ++i) { const float keep = (cl & 4) ? yp[i + 4] : yp[i], send = (cl & 4) ? yp[i] : yp[i + 4]; yp[i] = keep + dppf<0x141>(send); }
#pragma unroll
                    for (int i = 0; i < 2; ++i) { const float keep = (cl & 2) ? yp[i + 2] : yp[i], send = (cl & 2) ? yp[i] : yp[i + 2]; yp[i] = keep + dppf<0x4E>(send); }
                    { const float keep = (cl & 1) ? yp[1] : yp[0], send = (cl & 1) ? yp[0] : yp[1]; yp[0] = keep + dppf<0xB1>(send); }
                    yout[(size_t)(tile * 32 + hlf * 16) * 1024] = f2bf(yp[0]);
                }
            } else if (tile + 1 < 256) {
                ld_process(q, lds + ((tile + 1) & 1) * WK_BUF, lds, ltt, cg, c7, false);
                if (tile + 2 < 256) ld_load(q, ws, b, h, rq, (tile + 2) * 32 + ltt, cg, c7 & 1);
            }
            __syncthreads();
        }
    }
}

typedef short bf16x4 __attribute__((ext_vector_type(4)));
template <bool OUT>
__device__ void phase_s5(const Params& p, unsigned char* ldsg) {
    LAS unsigned char* lds = (LAS unsigned char*)ldsg;
    const int tid = threadIdx.x, lane = tid & 63, wave = __builtin_amdgcn_readfirstlane(tid >> 6);
    unsigned char* ws = p.ws;
    LAS unsigned char* BUT = lds + wave * 14592;
    LAS unsigned char* SS = lds + wave * 14592 + 10240;
    const bf16_t* zu = (const bf16_t*)(ws + WS_ZU); bf16_t* ysg = (bf16_t*)((unsigned char*)p.out + OUT_YSG);
    const bf16_t* bbt = (const bf16_t*)(ws + WS_S5C + S5_BBRE);
    const int fr = lane & 15, fq = lane >> 4;
    for (int item = blockIdx.x; item < 512; item += gridDim.x) {
        const int b = item >> 7, c = (item >> 2) & 31, gq = item & 3, g = gq * 8 + wave;
        const f32x2 ab = ((const f32x2*)(ws + WS_S5C + S5_AB))[g * 64 + lane];
        bf16x4 bbf[8];
#pragma unroll
        for (int nt = 0; nt < 8; ++nt) bbf[nt] = *(const bf16x4*)(bbt + ((size_t)(g * 128 + nt * 16 + fr) * 16 + fq * 4));
        float sre = 0.f, sim = 0.f;
        bf16x8 cmf[4]; float dsk = 0.f;
        if (OUT) { const f32x2 ap = ((const f32x2*)(ws + WS_S5C + S5_APOW))[g * 64 + lane];
            const f32x2* sl = (const f32x2*)(ws + WS_SLOC) + (size_t)(b * 32 + g) * 32 * 64 + lane;
            for (int cc0 = 0; cc0 < c; cc0 += 8) {
                f32x2 e[8];
#pragma unroll
                for (int i = 0; i < 8; ++i) e[i] = (cc0 + i < c) ? sl[(cc0 + i) * 64] : (f32x2){0.f, 0.f};
#pragma unroll
                for (int i = 0; i < 8; ++i) if (cc0 + i < c) { const float nr = ap[0] * sre - ap[1] * sim + e[i][0], ni = ap[0] * sim + ap[1] * sre + e[i][1]; sre = nr; sim = ni; }
            }
#pragma unroll
            for (int ks = 0; ks < 4; ++ks) cmf[ks] = *(const bf16x8*)((const bf16_t*)(ws + WS_S5C + S5_CMT) + (size_t)(g * 16 + fr) * 128 + ks * 32 + fq * 8);
            dsk = p.in[20][g * 16 + fr]; }
        const size_t tok0 = (size_t)b * SEQ + (size_t)c * 256;
        if (!OUT) {
            f32x2 lam[4], l16[4], wq[4], T[4];
#pragma unroll
            for (int k = 0; k < 4; ++k) {
                const f32x2 l1 = ((const f32x2*)(ws + WS_S5C + S5_AB))[g * 64 + fr + 16 * k];
                const f32x2 l2 = (f32x2){l1[0] * l1[0] - l1[1] * l1[1], 2.f * l1[0] * l1[1]};
                const f32x2 l4 = (f32x2){l2[0] * l2[0] - l2[1] * l2[1], 2.f * l2[0] * l2[1]};
                const f32x2 l8 = (f32x2){l4[0] * l4[0] - l4[1] * l4[1], 2.f * l4[0] * l4[1]};
                const f32x2 l12 = (f32x2){l8[0] * l4[0] - l8[1] * l4[1], l8[0] * l4[1] + l8[1] * l4[0]};
                lam[k] = l1; l16[k] = (f32x2){l8[0] * l8[0] - l8[1] * l8[1], 2.f * l8[0] * l8[1]};
                wq[k] = (fq == 3) ? (f32x2){1.f, 0.f} : (fq == 2) ? l4 : (fq == 1) ? l8 : l12;
                T[k] = (f32x2){0.f, 0.f};
            }
            bf16x4 aq = *(const bf16x4*)(zu + (tok0 + fr) * 512 + g * 16 + fq * 4);
            for (int st = 0; st < 16; ++st) {
                const bf16x4 acur = aq;
                if (st + 1 < 16) aq = *(const bf16x4*)(zu + (tok0 + (st + 1) * 16 + fr) * 512 + g * 16 + fq * 4);
                f32x4 d[8];
#pragma unroll
                for (int nt = 0; nt < 8; ++nt) d[nt] = __builtin_amdgcn_mfma_f32_16x16x16bf16_1k(acur, bbf[nt], (f32x4){0.f, 0.f, 0.f, 0.f}, 0, 0, 0);
#pragma unroll
                for (int k = 0; k < 4; ++k) {
                    float xr = d[k][0], xi = d[4 + k][0];
#pragma unroll
                    for (int j = 1; j < 4; ++j) { const float nr = lam[k][0] * xr - lam[k][1] * xi + d[k][j], ni = lam[k][0] * xi + lam[k][1] * xr + d[4 + k][j]; xr = nr; xi = ni; }
                    const float tr = l16[k][0] * T[k][0] - l16[k][1] * T[k][1] + xr, ti = l16[k][0] * T[k][1] + l16[k][1] * T[k][0] + xi;
                    T[k] = (f32x2){tr, ti};
                }
            }
            float outr = 0.f, outi = 0.f;
#pragma unroll
            for (int k = 0; k < 4; ++k) {
                float cr = wq[k][0] * T[k][0] - wq[k][1] * T[k][1], ci = wq[k][0] * T[k][1] + wq[k][1] * T[k][0];
                cr += __shfl_xor(cr, 16); cr += __shfl_xor(cr, 32); ci += __shfl_xor(ci, 16); ci += __shfl_xor(ci, 32);
                if (fq == k) { outr = cr; outi = ci; }
            }
            ((f32x2*)(ws + WS_SLOC))[((size_t)(b * 32 + g) * 32 + c) * 64 + fr + 16 * fq] = (f32x2){outr, outi};
            continue;
        }
        bf16x4 au = *(const bf16x4*)(zu + (tok0 + fr) * 512 + g * 16 + fq * 4);
        for (int st = 0; st < 16; ++st) {
            const size_t tb = tok0 + st * 16;
            const bf16x4 acur = au;
            unsigned short uraw[4];
            if (OUT) {
#pragma unroll
                for (int j = 0; j < 4; ++j) uraw[j] = zu[(tb + fq * 4 + j) * 512 + g * 16 + fr];
            }
            if (st + 1 < 16) au = *(const bf16x4*)(zu + (tb + 16 + fr) * 512 + g * 16 + fq * 4);
#pragma unroll
            for (int nt = 0; nt < 8; ++nt) {
                const f32x4 d = __builtin_amdgcn_mfma_f32_16x16x16bf16_1k(acur, bbf[nt], (f32x4){0.f, 0.f, 0.f, 0.f}, 0, 0, 0);
                *(LAS f32x4*)(BUT + (nt * 16 + fr) * 80 + fq * 16) = d;
            }
            wave_lds_sync();
            f32x4 bre[4], bim[4];
#pragma unroll
            for (int q4 = 0; q4 < 4; ++q4) { bre[q4] = *(const LAS f32x4*)(BUT + lane * 80 + q4 * 16); bim[q4] = *(const LAS f32x4*)(BUT + (64 + lane) * 80 + q4 * 16); }
#pragma unroll
            for (int tt = 0; tt < 16; ++tt) {
                const float bur = bre[tt >> 2][tt & 3], bui = bim[tt >> 2][tt & 3];
                const float nre = ab[0] * sre - ab[1] * sim + bur, nim = ab[0] * sim + ab[1] * sre + bui;
                sre = nre; sim = nim;
                if (OUT) *(LAS unsigned*)(SS + tt * 272 + lane * 4) = pk2bf(sre, sim);
            }
            if (OUT) {
                wave_lds_sync();
                f32x4 acc = (f32x4){0.f, 0.f, 0.f, 0.f};
#pragma unroll
                for (int ks = 0; ks < 4; ++ks) { const bf16x8 a = *(const LAS bf16x8*)(SS + fr * 272 + (ks * 32 + fq * 8) * 2); acc = __builtin_amdgcn_mfma_f32_16x16x32_bf16(a, cmf[ks], acc, 0, 0, 0); }
#pragma unroll
                for (int j = 0; j < 4; ++j) ysg[(tb + fq * 4 + j) * 512 + g * 16 + fr] = f2bf(fgelu_tanh(acc[j] + dsk * bf2f(uraw[j])));
            }
            wave_lds_sync();
        }
        if (!OUT) ((f32x2*)(ws + WS_SLOC))[((size_t)(b * 32 + g) * 32 + c) * 64 + lane] = (f32x2){sre, sim};
    }
}
__device__ void phase_s5_carry(const Params& p) {
    unsigned char* ws = p.ws;
    const int gid = blockIdx.x * 512 + threadIdx.x;
    if (gid < 8192) {
        const int b = gid >> 11, g = (gid >> 6) & 31, pp = gid & 63;
        const f32x2 ap = ((const f32x2*)(ws + WS_S5C + S5_APOW))[g * 64 + pp];
        const f32x2* sl = (const f32x2*)(ws + WS_SLOC) + (size_t)(b * 32 + g) * 32 * 64 + pp; f32x2* st = (f32x2*)(ws + WS_SSTART) + (size_t)(b * 32 + g) * 32 * 64 + pp;
        float cr = 0.f, ci = 0.f;
#pragma unroll 8
        for (int c = 0; c < 32; ++c) { st[c * 64] = (f32x2){cr, ci}; const f32x2 e = sl[c * 64];
            const float nr = ap[0] * cr - ap[1] * ci + e[0], ni = ap[0] * ci + ap[1] * cr + e[1]; cr = nr; ci = ni; }
    }
}

struct YaRaw { u32x4 y0, y1, a0, a1, b0, b1, g0, g1; float rk; };
__device__ __forceinline__ void ya_load(YaRaw& q, const bf16_t* yraw, const bf16_t* zv, const bf16_t* zga, const float* rkb, int row, int c0, int hh) {
    const bool first = (row & (SEQ - 1)) == 0; const size_t ro = (size_t)row * 1024 + c0; const size_t rp = first ? ro : ro - 1024;
    q.y0 = *(const u32x4*)(yraw + ro); q.y1 = *(const u32x4*)(yraw + ro + 8);
    q.a0 = *(const u32x4*)(zv + ro); q.a1 = *(const u32x4*)(zv + ro + 8); q.b0 = *(const u32x4*)(zv + rp); q.b1 = *(const u32x4*)(zv + rp + 8);
    q.g0 = *(const u32x4*)(zga + ro); q.g1 = *(const u32x4*)(zga + ro + 8); q.rk = rkb[(size_t)row * 16 + hh];
}
__device__ void phase_ya(const Params& p) {
    const int tid = threadIdx.x, lane = tid & 63, wave = tid >> 6;
    unsigned char* ws = p.ws;
    const bf16_t* yraw = (const bf16_t*)p.out; const float* rkb = (const float*)(ws + WS_RK);
    const bf16_t* zv = (const bf16_t*)(ws + WS_ZV); const bf16_t* zga = (const bf16_t*)(ws + WS_ZGA); bf16_t* ya = (bf16_t*)(ws + WS_YA);
    const int c0 = lane * 16, hh = lane >> 2;
    float lg[16], lb[16], mv[16];
#pragma unroll
    for (int i = 0; i < 4; ++i) { const f32x4 a = *(const f32x4*)(p.in[11] + c0 + i * 4), bq = *(const f32x4*)(p.in[12] + c0 + i * 4), m = *(const f32x4*)(p.in[3] + 2048 + c0 + i * 4);
#pragma unroll
        for (int e = 0; e < 4; ++e) { lg[i * 4 + e] = a[e]; lb[i * 4 + e] = bq[e]; mv[i * 4 + e] = m[e]; } }
    YaRaw q;
    { const int row = blockIdx.x * 8 + wave; if (row < NTOK) ya_load(q, yraw, zv, zga, rkb, row, c0, hh); }
    for (int row = blockIdx.x * 8 + wave; row < NTOK; row += gridDim.x * 8) {
        const bool first = (row & (SEQ - 1)) == 0; const size_t ro = (size_t)row * 1024 + c0;
        const YaRaw c = q;
        if (row + (int)gridDim.x * 8 < NTOK) ya_load(q, yraw, zv, zga, rkb, row + (int)gridDim.x * 8, c0, hh);
        float y[16];
        UNPACK8(c.y0, y); UNPACK8(c.y1, y + 8);
        float s = 0.f;
#pragma unroll
        for (int e = 0; e < 16; ++e) s += y[e];
        const float mean = allred4(s) * (1.0f / 64.0f);
        float s2 = 0.f;
#pragma unroll
        for (int e = 0; e < 16; ++e) { const float d = y[e] - mean; s2 += d * d; }
        const float rstd = rsqrtf(allred4(s2) * (1.0f / 64.0f) + 64e-5f);
        const float rk = c.rk;
        float vc[16], vp[16], ga[16];
        UNPACK8(c.a0, vc); UNPACK8(c.a1, vc + 8); UNPACK8(c.b0, vp); UNPACK8(c.b1, vp + 8); UNPACK8(c.g0, ga); UNPACK8(c.g1, ga + 8);
        float o[16];
#pragma unroll
        for (int e = 0; e < 16; ++e) { const float pv = first ? 0.f : vp[e]; const float v = vc[e] + mv[e] * (pv - vc[e]);
            const float yn = (y[e] - mean) * rstd * lg[e] + lb[e] + rk * v; o[e] = yn * ga[e] * fsigmoid(ga[e]); }
        u32x4 w0, w1; w0.x = pk2bf(o[0], o[1]); w0.y = pk2bf(o[2], o[3]); w0.z = pk2bf(o[4], o[5]); w0.w = pk2bf(o[6], o[7]);
        w1.x = pk2bf(o[8], o[9]); w1.y = pk2bf(o[10], o[11]); w1.z = pk2bf(o[12], o[13]); w1.w = pk2bf(o[14], o[15]);
        *(u32x4*)(ya + ro) = w0; *(u32x4*)(ya + ro + 8) = w1;
    }
}

struct FnRaw { f32x4 x0, x1, x2, x3; u32x4 o0, o1; };
__device__ __forceinline__ void fn_load(FnRaw& q, const float* x, const bf16_t* ob, int row, int lane) {
    const float* xp = x + (size_t)row * 1024 + lane * 16; const bf16_t* op = ob + (size_t)row * 1024 + lane * 16;
    q.x0 = *(const f32x4*)(xp); q.x1 = *(const f32x4*)(xp + 4); q.x2 = *(const f32x4*)(xp + 8); q.x3 = *(const f32x4*)(xp + 12);
    q.o0 = *(const u32x4*)(op); q.o1 = *(const u32x4*)(op + 8);
}
__device__ void phase_final_norm(const Params& p) {
    const int tid = threadIdx.x, lane = tid & 63, wave = tid >> 6;
    float* out = p.out; const float* fg = p.in[26]; const float* x = p.in[0]; const bf16_t* ob = (const bf16_t*)(p.ws + WS_OB);
    f32x4 gv[4];
#pragma unroll
    for (int i = 0; i < 4; ++i) gv[i] = *(const f32x4*)(fg + lane * 16 + i * 4);
    const int rstep = (int)gridDim.x * 8;
    FnRaw q;
    { const int row = blockIdx.x * 8 + wave; if (row < NTOK) fn_load(q, x, ob, row, lane); }
    for (int row = blockIdx.x * 8 + wave; row < NTOK; row += rstep) {
        const FnRaw c = q;
        if (row + rstep < NTOK) fn_load(q, x, ob, row + rstep, lane);
        float o[16]; UNPACK8(c.o0, o); UNPACK8(c.o1, o + 8);
        f32x4 v[4];
        v[0] = c.x0 + (f32x4){o[0], o[1], o[2], o[3]}; v[1] = c.x1 + (f32x4){o[4], o[5], o[6], o[7]};
        v[2] = c.x2 + (f32x4){o[8], o[9], o[10], o[11]}; v[3] = c.x3 + (f32x4){o[12], o[13], o[14], o[15]};
        float ss = 0.f;
#pragma unroll
        for (int i = 0; i < 4; ++i) ss += v[i][0] * v[i][0] + v[i][1] * v[i][1] + v[i][2] * v[i][2] + v[i][3] * v[i][3];
        ss = allred64(ss);
        const float rs = rsqrtf(ss * (1.0f / 1024.0f) + 1e-6f);
#pragma unroll
        for (int i = 0; i < 4; ++i) *(f32x4*)(out + (size_t)row * 1024 + lane * 16 + i * 4) = v[i] * gv[i] * rs;
    }
}

#define XB_TMO      128
#define XB_XCNT(j)  (256  + 64 * (j))
#define XB_XSUB(j)  (1280 + 64 * (j))
#define XB_XGEN(j)  (2304 + 64 * (j))
#define XB_TOP      3328
#define XB_TOPGEN   3392
#define XCD_BAR_WORDS 3456
#define XB_SPIN_CAP (1u << 18)
__device__ __forceinline__ unsigned xb_ld(unsigned* p)              { return __hip_atomic_load(p, __ATOMIC_RELAXED, __HIP_MEMORY_SCOPE_AGENT); }
__device__ __forceinline__ unsigned xb_add(unsigned* p, unsigned v) { return __hip_atomic_fetch_add(p, v, __ATOMIC_RELAXED, __HIP_MEMORY_SCOPE_AGENT); }
__device__ __forceinline__ unsigned xb_xcc_id() { return (unsigned)__builtin_amdgcn_s_getreg((3 << 11) | 20) & 0xFu; }
#define XB_SPIN(cond, bar) do { unsigned _sp = 0; while (cond) { __builtin_amdgcn_s_sleep(1); \
    if ((++_sp & 255u) == 0u) { if (xb_ld(&(bar)[XB_TMO])) break; if (_sp > XB_SPIN_CAP) { atomicAdd(&(bar)[XB_TMO], 1u); break; } } } } while (0)
struct XcdBarrier { unsigned* bar; unsigned x; volatile LAS unsigned* st; };
__device__ __forceinline__ XcdBarrier xcd_barrier_post(unsigned* bar, volatile LAS unsigned* st) {
    XcdBarrier b; b.bar = bar; b.x = xb_xcc_id(); b.st = st;
    if (threadIdx.x == 0) { st[2] = xb_add(&bar[XB_XCNT(b.x)], 1u); st[3] = b.x; }
    return b;
}
__device__ __forceinline__ void xcd_barrier_complete(unsigned* bar, unsigned x, unsigned& nloc, unsigned& nx) {
    const unsigned G = gridDim.x * gridDim.y * gridDim.z;
    unsigned sum, cnt, mine, sp = 0u;
    for (;;) {
        sum = 0u; cnt = 0u; mine = 0u;
#pragma unroll
        for (unsigned j = 0; j < 16; ++j) { const unsigned c = xb_ld(&bar[XB_XCNT(j)]); sum += c; cnt += (c > 0u) ? 1u : 0u; mine = (j == x) ? c : mine; }
        if (sum == G) break;
        __builtin_amdgcn_s_sleep(1);
        if ((++sp & 255u) == 0u) { if (xb_ld(&bar[XB_TMO])) break; if (sp > XB_SPIN_CAP) { atomicAdd(&bar[XB_TMO], 1u); break; } }
    }
    nloc = mine > 0u ? mine : 1u; nx = cnt > 0u ? cnt : 1u;
}
__device__ __forceinline__ void xcd_barrier(const XcdBarrier& b) {
    asm volatile("s_waitcnt vmcnt(0)" ::: "memory");
    __syncthreads();
    if (threadIdx.x == 0) {
        unsigned* bar = b.bar;
        __builtin_amdgcn_s_waitcnt(0);
        unsigned nloc = b.st[0], nx = b.st[1];
        if (nloc == 0u) { xcd_barrier_complete(bar, b.x, nloc, nx); b.st[0] = nloc; b.st[1] = nx; }
        const unsigned old = xb_add(&bar[XB_XSUB(b.x)], 1u);
        const unsigned gen = old / nloc;
        if (old + 1u == (gen + 1u) * nloc) {
            __builtin_amdgcn_fence(__ATOMIC_RELEASE, "agent");
            asm volatile("s_waitcnt vmcnt(0)" ::: "memory");
            const unsigned og = xb_add(&bar[XB_TOP], 1u);
            const unsigned tg = og / nx;
            if (og + 1u == (tg + 1u) * nx) xb_add(&bar[XB_TOPGEN], 1u);
            else XB_SPIN(xb_ld(&bar[XB_TOPGEN]) == tg, bar);
            __builtin_amdgcn_fence(__ATOMIC_ACQUIRE, "agent");
            xb_add(&bar[XB_XGEN(b.x)], 1u);
            asm volatile("s_waitcnt vmcnt(0)" ::: "memory");
        } else {
            XB_SPIN(xb_ld(&bar[XB_XGEN(b.x)]) == gen, bar);
            __builtin_amdgcn_fence(__ATOMIC_ACQUIRE, "agent");
            asm volatile("s_waitcnt vmcnt(0)" ::: "memory");
        }
    }
    __syncthreads();
}

__global__ void __launch_bounds__(512, 2) mega_fwd(Params p) {
    extern __shared__ __attribute__((aligned(16))) unsigned char lds[];
    unsigned char* ws = p.ws;
    volatile LAS unsigned* xst = (volatile LAS unsigned*)((LAS unsigned char*)lds + 131072);
    if (threadIdx.x < 8) xst[threadIdx.x] = 0u;
    __syncthreads();
    XcdBarrier xbar = xcd_barrier_post((unsigned*)ws, xst);
#ifndef PHASE_MASK
#define PHASE_MASK 0xfff
#endif
#define PH_ON(n) ((PHASE_MASK >> (n)) & 1)
#ifndef REPEAT_MASK
#define REPEAT_MASK 0
#endif
#define PH_BEGIN(n) if (PH_ON(n) && p.ph_lo <= (n) && (n) < p.ph_hi) { for (int _r = 0; _r <= ((REPEAT_MASK >> (n)) & 1); ++_r) {
#define PH_END(n) } if ((n) + 1 < p.ph_hi) { xcd_barrier(xbar); } }
    unsigned char* ob = (unsigned char*)p.out;
    if (p.ph_lo < 0) cg::this_grid().sync();
    PH_BEGIN(0) phase_prologue(p, lds); PH_END(0)
    int vb = (int)blockIdx.x;
    if (p.ph_hi - p.ph_lo > 1) {
        if (threadIdx.x == 0) { unsigned okc = ((gridDim.x & 7u) == 0u) ? 1u : 0u;
            for (unsigned j = 0; j < 16; ++j) { const unsigned cnt = xb_ld((unsigned*)ws + XB_XCNT(j)); if (cnt != ((j < 8) ? gridDim.x / 8u : 0u)) okc = 0u; }
            xst[1 + 4] = okc; }
        __syncthreads();
        if (xst[5] != 0u) vb = (int)(xst[2] * 8u + xst[3]);
        __syncthreads();
    }
    PH_BEGIN(1) { pg8::StaticOrder S; pg8::Gemm g{(const bf16_t*)p.out, (const bf16_t*)(ws + WS_WIN), NTOK, INWP, 1024}; S.init(g.M, 7168, (int)gridDim.x, vb); S.tailN = 2 * S.nM; S.tailNt = 8;
                  EpiZ E{ws}; pg8::gemm_phase((LAS unsigned char*)lds, g, S, E); } PH_END(1)
    PH_BEGIN(2) phase_s5<false>(p, lds); PH_END(2)
    PH_BEGIN(3) phase_s5<true>(p, lds); PH_END(3)
    PH_BEGIN(4) { pg8::StaticOrder S; pg8::Gemm g{(const bf16_t*)(ob + OUT_YSG), (const bf16_t*)(ws + WS_WGLU), NTOK, 1024, 512}; S.init(g.M, g.N, (int)gridDim.x, vb);
                  EpiGlu E{ws, p.in[22], (bf16_t*)(ob + OUT_YB)}; pg8::gemm_phase((LAS unsigned char*)lds, g, S, E); } PH_END(4)
    PH_BEGIN(5) { pg8::StaticOrder S; pg8::Gemm g{(const bf16_t*)(ob + OUT_YB), (const bf16_t*)(ws + WS_WPB), NTOK, 1024, 512}; S.init(g.M, g.N, (int)gridDim.x, vb);
                  EpiGate<0> E{(const bf16_t*)(ws + WS_ZMB), nullptr, (bf16_t*)(ob + OUT_MB)}; pg8::gemm_phase((LAS unsigned char*)lds, g, S, E); } PH_END(5)
    PH_BEGIN(6) phase_prep(p, lds); PH_END(6)
    PH_BEGIN(7) phase_wkv(p, lds, vb); PH_END(7)
    PH_BEGIN(8) phase_ya(p); PH_END(8)
    PH_BEGIN(9) { pg8::StaticOrder S; pg8::Gemm g{(const bf16_t*)(ws + WS_YA), (const bf16_t*)(ws + WS_WPA), NTOK, 1024, 1024}; S.init(g.M, g.N, (int)gridDim.x, vb);
                  EpiGate<1> E{(const bf16_t*)(ws + WS_ZMA), (const bf16_t*)(ob + OUT_MB), (bf16_t*)(ws + WS_MERGED)}; pg8::gemm_phase((LAS unsigned char*)lds, g, S, E); } PH_END(9)
    PH_BEGIN(10) { pg8::StaticOrder S; pg8::Gemm g{(const bf16_t*)(ws + WS_MERGED), (const bf16_t*)(ws + WS_WOUT), NTOK, 1024, 1024}; S.init(g.M, g.N, (int)gridDim.x, vb);
                  EpiOut E{(bf16_t*)(ws + WS_OB)}; pg8::gemm_phase((LAS unsigned char*)lds, g, S, E); } PH_END(10)
#ifdef EXTRA_SYNCS
    for (int _e = 0; _e < EXTRA_SYNCS; ++_e) cg::this_grid().sync();
#endif
    PH_BEGIN(11) phase_final_norm(p); PH_END(11)
}

extern "C" void kernel_launch(void* const* d_in, const int* in_sizes, int n_in, void* d_out, int out_size, void* d_ws, size_t ws_size, hipStream_t stream) {
    static int grid = 0;
    if (grid == 0) {
        if (n_in != 27 || out_size != NTOK * DM || ws_size < WS_END) { fprintf(stderr, "kernel_launch: unexpected sizes (n_in %d out %d ws %zu, need %zu)\n", n_in, out_size, ws_size, (size_t)WS_END); grid = -1; return; }
        int dev = 0, cus = 0, per_cu = 0;
        (void)hipGetDevice(&dev); (void)hipDeviceGetAttribute(&cus, hipDeviceAttributeMultiprocessorCount, dev);
        if (hipFuncSetAttribute((const void*)mega_fwd, hipFuncAttributeMaxDynamicSharedMemorySize, LDS_BYTES) != hipSuccess) { fprintf(stderr, "kernel_launch: hipFuncSetAttribute failed\n"); grid = -1; return; }
        if (hipOccupancyMaxActiveBlocksPerMultiprocessor(&per_cu, (const void*)mega_fwd, 512, LDS_BYTES) != hipSuccess || per_cu < 1) { fprintf(stderr, "kernel_launch: occupancy query says %d blocks/CU\n", per_cu); per_cu = 1; }
        (void)hipGetLastError();
        grid = cus > 0 ? cus : 256;
    }
    if (grid < 0) return;
    if (hipMemsetAsync(d_ws, 0, XCD_BAR_WORDS * 4, stream) != hipSuccess) { fprintf(stderr, "kernel_launch: memset failed\n"); return; }
    Params p{};
    for (int i = 0; i < 27; ++i) p.in[i] = (const float*)d_in[i];
    p.out = (float*)d_out; p.ws = (unsigned char*)d_ws;
#if MK_MULTI
    for (int ph = 0; ph < NPHASE; ++ph) { p.ph_lo = ph; p.ph_hi = ph + 1; hipLaunchKernelGGL(mega_fwd, dim3(grid), dim3(512), LDS_BYTES, stream, p); }
#else
    p.ph_lo = 0; p.ph_hi = NPHASE;
    void* args[] = {&p};
    hipError_t e = hipLaunchCooperativeKernel((const void*)mega_fwd, dim3(grid), dim3(512), args, LDS_BYTES, stream);
    if (e != hipSuccess) fprintf(stderr, "kernel_launch: cooperative launch failed: %s (grid %d)\n", hipGetErrorString(e), grid);
#endif
}
```
